# Optimizing an MI355X kernel written in HIP

```python
import jax, jax.numpy as jnp
from jax import lax
import numpy as np


D_MODEL = 2048
BATCH = 1
SEQ = 8192
DEPTH = 1

GRID_W = 64
CTX_LEN = 256
D_MIX = D_MODEL
ATT_WIDTH = D_MIX // 2
HEAD_DIM = 128
N_Q_HEADS = ATT_WIDTH // HEAD_DIM
N_KV_HEADS = N_Q_HEADS // 4
Q_PER_KV = N_Q_HEADS // N_KV_HEADS
AXIS_DIM = HEAD_DIM // 2
ROPE_THETA = 10000.0
Q_BLOCK = 128
M_WIDTH = D_MIX - ATT_WIDTH
M_HEADS = 4
M_V = M_WIDTH // M_HEADS
M_QK = M_V // 2
M_CHUNK = 64
N_DIR = 2
D_FF = 5632
CONV_W = 3
NORM_EPS = 1e-6

OFF_AQ = 0
OFF_AK = OFF_AQ + N_Q_HEADS * HEAD_DIM
OFF_AV = OFF_AK + N_KV_HEADS * HEAD_DIM
OFF_MQ = OFF_AV + N_KV_HEADS * HEAD_DIM
OFF_MK = OFF_MQ + M_HEADS * M_QK
OFF_MV = OFF_MK + M_HEADS * M_QK
OFF_MO = OFF_MV + M_WIDTH
OFF_G = OFF_MO + M_WIDTH
IN_PROJ = OFF_G + N_DIR * 2 * M_HEADS

kernel_name = 'hybrid_mlstm_gqa_convffn_dit_layer'


def rmsnorm(x, g):
    xf = x.astype(jnp.float32)
    xf = xf * lax.rsqrt(jnp.mean(xf * xf, axis=-1, keepdims=True) + NORM_EPS)
    return xf.astype(x.dtype) * g


def modulate(h, shift, scale):
    return h * (1.0 + scale) + shift


def rope_rotate(x, cos, sin):
    r = x.shape[-1] // 2
    x1, x2 = x[..., :r], x[..., r:]
    c = cos[None, :, None, :]
    s = sin[None, :, None, :]
    return jnp.concatenate([x1 * c - x2 * s, x2 * c + x1 * s], axis=-1)


def axial_rope(x, cos_r, sin_r, cos_c, sin_c):
    return jnp.concatenate([rope_rotate(x[..., :AXIS_DIM], cos_r, sin_r),
                            rope_rotate(x[..., AXIS_DIM:], cos_c, sin_c)], axis=-1)


def attn_qkv(p, q_gain, k_gain):
    B, T, _ = p.shape
    q = p[..., OFF_AQ:OFF_AK].reshape(B, T, N_Q_HEADS, HEAD_DIM)
    k = p[..., OFF_AK:OFF_AV].reshape(B, T, N_KV_HEADS, HEAD_DIM)
    v = p[..., OFF_AV:OFF_MQ].reshape(B, T, N_KV_HEADS, HEAD_DIM)
    return rmsnorm(q, q_gain), rmsnorm(k, k_gain), v


def block_attention(q, k, v):
    B, T = q.shape[:2]
    nb = T // Q_BLOCK
    qb = q.reshape(B, nb, Q_BLOCK, N_KV_HEADS, Q_PER_KV, HEAD_DIM).swapaxes(0, 1)
    scale = HEAD_DIM ** -0.5

    def one_block(qblk):
        s = jnp.einsum('bqkgd,bskd->bkgqs', qblk, k).astype(jnp.float32) * scale
        p = jax.nn.softmax(s, axis=-1).astype(v.dtype)
        return jnp.einsum('bkgqs,bskd->bqkgd', p, v)

    o = lax.map(one_block, qb)
    return o.swapaxes(0, 1).reshape(B, T, N_Q_HEADS * HEAD_DIM)


def mlstm_inputs(p, b_i, b_f):
    B, T, _ = p.shape
    f32 = jnp.float32
    q = p[..., OFF_MQ:OFF_MK].reshape(B, T, M_HEADS, M_QK)
    k = p[..., OFF_MK:OFF_MV].reshape(B, T, M_HEADS, M_QK) * (M_QK ** -0.5)
    v = p[..., OFF_MV:OFF_MO].reshape(B, T, M_HEADS, M_V)
    o = jax.nn.sigmoid(p[..., OFF_MO:OFF_G])
    g = p[..., OFF_G:IN_PROJ].astype(f32).reshape(B, T, N_DIR, 2, M_HEADS)
    i_pre = g[:, :, :, 0] + b_i.astype(f32)
    logf = jax.nn.log_sigmoid(g[:, :, :, 1] + b_f.astype(f32))
    return q, k, v, o, i_pre, logf


def zero_state(batch):
    f32 = jnp.float32
    return (jnp.zeros((batch, M_HEADS, M_QK, M_V), f32),
            jnp.zeros((batch, M_HEADS, M_QK), f32),
            jnp.zeros((batch, M_HEADS), f32))


def mlstm_scan(q, k, v, i_pre, logf, state):
    B, T, H, _ = q.shape
    nc = T // M_CHUNK

    def chunks(a):
        a = a.astype(jnp.float32).reshape((B, nc, M_CHUNK) + a.shape[2:])
        return a.transpose((1, 0, 3, 2) + tuple(range(4, a.ndim)))

    tril = jnp.tril(jnp.ones((M_CHUNK, M_CHUNK), dtype=bool))

    def step(carry, inp):
        C, n, m = carry
        qc, kc, vc, ic, fc = inp
        b = jnp.cumsum(fc, axis=-1)
        log_d = jnp.where(tril, b[..., :, None] - b[..., None, :] + ic[..., None, :], -jnp.inf)
        log_inter = b + m[..., None]
        m_t = jnp.maximum(jnp.max(log_d, axis=-1), log_inter)
        d = jnp.exp(log_d - m_t[..., None])
        w_inter = jnp.exp(log_inter - m_t)
        s = jnp.einsum('bhld,bhsd->bhls', qc, kc) * d
        num = w_inter[..., None] * jnp.einsum('bhld,bhde->bhle', qc, C) + jnp.einsum('bhls,bhse->bhle', s, vc)
        den = w_inter * jnp.einsum('bhld,bhd->bhl', qc, n) + jnp.sum(s, axis=-1)
        h = num / jnp.maximum(jnp.abs(den), jnp.exp(-m_t))[..., None]
        b_last = b[..., -1:]
        log_w = b_last - b + ic
        m_new = jnp.maximum(b_last[..., 0] + m, jnp.max(log_w, axis=-1))
        w_prev = jnp.exp(b_last[..., 0] + m - m_new)
        kw = kc * jnp.exp(log_w - m_new[..., None])[..., None]
        C_new = w_prev[..., None, None] * C + jnp.einsum('bhsd,bhse->bhde', kw, vc)
        n_new = w_prev[..., None] * n + jnp.sum(kw, axis=2)
        return (C_new, n_new, m_new), h

    new_state, hs = lax.scan(step, state, (chunks(q), chunks(k), chunks(v), chunks(i_pre), chunks(logf)))
    h = hs.transpose(1, 0, 3, 2, 4).reshape(B, T, H, v.shape[-1])
    return h.astype(v.dtype), new_state


def mlstm_bidir(q, k, v, i_pre, logf, state_f, state_b):
    hf, sf = mlstm_scan(q, k, v, i_pre[:, :, 0], logf[:, :, 0], state_f)
    rev = lambda a: jnp.flip(a, axis=1)
    hb, sb = mlstm_scan(rev(q), rev(k), rev(v), rev(i_pre[:, :, 1]), rev(logf[:, :, 1]), state_b)
    return hf + rev(hb), sf, sb


def mlstm_readout(h, o, gain):
    B, T = h.shape[:2]
    h = rmsnorm(h, gain.reshape(M_HEADS, M_V))
    return h.reshape(B, T, M_WIDTH) * o


def conv_ffn(h, w_up, conv_w, conv_b, w_down):
    u = h @ w_up
    up = jnp.pad(u, ((0, 0), (1, 1), (0, 0)))
    u = conv_w[0] * up[:, :-2] + conv_w[1] * up[:, 1:-1] + conv_w[2] * up[:, 2:] + conv_b
    g, val = jnp.split(u, 2, axis=-1)
    return (jax.nn.silu(g) * val) @ w_down


def setup_inputs(seed: int = 0) -> dict:
    key = jax.random.key(seed)
    ks = jax.random.split(key, 20)
    f32 = jnp.float32
    nrm = lambda k, shape, s: jax.random.normal(k, shape, f32) * s
    gain = lambda k, shape: 1.0 + 0.01 * jax.random.normal(k, shape, f32)
    return {
        'x': nrm(ks[0], (BATCH, SEQ, D_MODEL), 1.0),
        'c': nrm(ks[1], (BATCH, D_MODEL), 1.0),
        'ctx': nrm(ks[2], (BATCH, CTX_LEN, D_MODEL), 1.0),
        'c_ctx': nrm(ks[3], (D_MODEL,), 1.0),
        'w_mod': nrm(ks[4], (DEPTH, D_MODEL, 6 * D_MODEL), 0.5 * D_MODEL ** -0.5),
        'b_mod': nrm(ks[5], (DEPTH, 6 * D_MODEL), 0.01),
        'norm1': gain(ks[6], (DEPTH, D_MODEL)),
        'w_in': nrm(ks[7], (DEPTH, D_MODEL, IN_PROJ), D_MODEL ** -0.5),
        'q_norm': gain(ks[8], (DEPTH, HEAD_DIM)),
        'k_norm': gain(ks[9], (DEPTH, HEAD_DIM)),
        'b_igate': -1.0 + nrm(ks[10], (DEPTH, N_DIR, M_HEADS), 0.1),
        'b_fgate': jnp.linspace(3.0, 6.0, M_HEADS, dtype=f32) + nrm(ks[11], (DEPTH, N_DIR, M_HEADS), 0.1),
        'm_norm': gain(ks[12], (DEPTH, M_WIDTH)),
        'w_out': nrm(ks[13], (DEPTH, D_MIX, D_MODEL), D_MIX ** -0.5),
        'norm2': gain(ks[14], (DEPTH, D_MODEL)),
        'w_up': nrm(ks[15], (DEPTH, D_MODEL, 2 * D_FF), D_MODEL ** -0.5),
        'conv_w': nrm(ks[16], (DEPTH, CONV_W, 2 * D_FF), CONV_W ** -0.5),
        'conv_b': nrm(ks[17], (DEPTH, 2 * D_FF), 0.01),
        'w_down': nrm(ks[18], (DEPTH, D_FF, D_MODEL), D_FF ** -0.5),
        'norm_f': gain(ks[19], (D_MODEL,)),
    }


def reference(x, c, ctx, c_ctx, w_mod, b_mod, norm1, w_in, q_norm, k_norm, b_igate, b_fgate,
              m_norm, w_out, norm2, w_up, conv_w, conv_b, w_down, norm_f):
    B, n_tok, _ = x.shape
    rows = n_tok // GRID_W
    row = jnp.repeat(jnp.arange(rows, dtype=jnp.float32), GRID_W)
    col = jnp.tile(jnp.arange(GRID_W, dtype=jnp.float32), rows)
    inv_freq = ROPE_THETA ** (-jnp.arange(0, AXIS_DIM, 2, dtype=jnp.float32) / AXIS_DIM)
    ang_r = row[:, None] * inv_freq[None, :]
    ang_c = col[:, None] * inv_freq[None, :]
    rope = (jnp.cos(ang_r).astype(x.dtype), jnp.sin(ang_r).astype(x.dtype),
            jnp.cos(ang_c).astype(x.dtype), jnp.sin(ang_c).astype(x.dtype))

    for layer in range(DEPTH):
        mod_x = (jax.nn.silu(c) @ w_mod[layer] + b_mod[layer])[:, None, :]
        mod_c = (jax.nn.silu(c_ctx) @ w_mod[layer] + b_mod[layer])[None, None, :]
        sh1x, sc1x, g1x, sh2x, sc2x, g2x = jnp.split(mod_x, 6, axis=-1)
        sh1c, sc1c, g1c, sh2c, sc2c, g2c = jnp.split(mod_c, 6, axis=-1)

        px = modulate(rmsnorm(x, norm1[layer]), sh1x, sc1x) @ w_in[layer]
        pc = modulate(rmsnorm(ctx, norm1[layer]), sh1c, sc1c) @ w_in[layer]

        qx, kx, vx = attn_qkv(px, q_norm[layer], k_norm[layer])
        qc, kc, vc = attn_qkv(pc, q_norm[layer], k_norm[layer])
        qx = axial_rope(qx, *rope)
        kx = axial_rope(kx, *rope)
        att_x = block_attention(qx, jnp.concatenate([kc, kx], axis=1), jnp.concatenate([vc, vx], axis=1))

        mq_c, mk_c, mv_c, mo_c, mi_c, mf_c = mlstm_inputs(pc, b_igate[layer], b_fgate[layer])
        mq_x, mk_x, mv_x, mo_x, mi_x, mf_x = mlstm_inputs(px, b_igate[layer], b_fgate[layer])
        h_c, st_f, st_b = mlstm_bidir(mq_c, mk_c, mv_c, mi_c, mf_c, zero_state(B), zero_state(B))
        h_x, _, _ = mlstm_bidir(mq_x, mk_x, mv_x, mi_x, mf_x, st_f, st_b)

        mix_x = jnp.concatenate([att_x, mlstm_readout(h_x, mo_x, m_norm[layer])], axis=-1)
        x = x + g1x * (mix_x @ w_out[layer])
        x = x + g2x * conv_ffn(modulate(rmsnorm(x, norm2[layer]), sh2x, sc2x),
                               w_up[layer], conv_w[layer], conv_b[layer], w_down[layer])

        if layer + 1 < DEPTH:
            att_c = block_attention(qc, kc, vc)
            mix_c = jnp.concatenate([att_c, mlstm_readout(h_c, mo_c, m_norm[layer])], axis=-1)
            ctx = ctx + g1c * (mix_c @ w_out[layer])
            ctx = ctx + g2c * conv_ffn(modulate(rmsnorm(ctx, norm2[layer]), sh2c, sc2c),
                                       w_up[layer], conv_w[layer], conv_b[layer], w_down[layer])

    return rmsnorm(x, norm_f)
```

```cpp
#include <hip/hip_runtime.h>
#include <hip/hip_cooperative_groups.h>
#include <cstdio>
#include <cstdint>
namespace cg = cooperative_groups;
__device__ __forceinline__ int ltid() { int t = threadIdx.x; asm volatile("" : "+v"(t)); return t; }
namespace pg8 {
#define PG8_LAS __attribute__((address_space(3)))
typedef unsigned short bf16_t;
typedef short bf16x8 __attribute__((ext_vector_type(8)));
typedef float f32x4 __attribute__((ext_vector_type(4)));
typedef unsigned u32x4 __attribute__((ext_vector_type(4)));
constexpr int BM = 256, BK = 64, HALF = 128, HTB = HALF * BK * 2  , STAGE_BYTES = 8 * HTB, NXCD = 8, WGM = 8;

__host__ __device__ __forceinline__ int lds_byte(int r, int c) { const int st = (r >> 4) * 2 + (c >> 5), rr = r & 15, cc = c & 31, ob = rr * 64 + cc * 2; return st * 1024 + (ob ^ (((ob >> 9) & 1) << 5)); }
__host__ __device__ __forceinline__ void stage_rc(int b, int& R, int& C) { const int st = b / 1024, sb = b % 1024, swz = sb ^ (((sb >> 9) & 1) << 5); R = (st >> 1) * 16 + swz / 64; C = (st & 1) * 32 + (swz % 64) / 2; }
__host__ __device__ __forceinline__ int perm32(int rho) { const int n = rho >> 4, i = rho & 15; return 8 * (i >> 2) + 4 * n + (i & 3); }

struct Unit { int pm, pn; };
struct Gemm { const bf16_t* A; const bf16_t* Bt; int M, N, K; int a_rows = 256; };

struct StaticOrder {
    int nM, nN, nwg, G, c;
    __host__ __device__ void init(int M, int N, int G_, int c_) { nM = M / BM; nN = N / BM; nwg = nM * nN; G = G_; c = c_; }
    __host__ __device__ bool next(int i, Unit& u) const {
        const long L = (long)i * G + c; if (L >= nwg) return false;
        int wgid = (int)L; { const int q = nwg / NXCD, r = nwg % NXCD, xcd = wgid % NXCD, off = wgid / NXCD; wgid = (xcd < r ? xcd * (q + 1) : r * (q + 1) + (xcd - r) * q) + off; }
        const int nig = WGM * nN, gid = wgid / nig, fm = gid * WGM, gsz = (nM - fm) < WGM ? (nM - fm) : WGM;
        u.pm = fm + ((wgid % nig) % gsz); u.pn = (wgid % nig) / gsz; return true;
    }
    __device__ __forceinline__ void a_ready(const Unit&) const {}
    __device__ __forceinline__ void done(const Unit&) const {}
};

typedef float f32x2 __attribute__((ext_vector_type(2)));
__device__ __forceinline__ unsigned cvt_pk_bf16(float lo, float hi) { typedef __bf16 bf16x2_ __attribute__((ext_vector_type(2))); const f32x2 v = {lo, hi}; const bf16x2_ b = __builtin_convertvector(v, bf16x2_); return __builtin_bit_cast(unsigned, b); }
#ifndef WT_STORES
#define WT_STORES 0
#endif
#if WT_STORES
__device__ __forceinline__ void st16_wt(void* p, u32x4 v) { asm volatile("global_store_dwordx4 %0, %1, off sc0 sc1" :: "v"(p), "v"(v) : "memory"); }
#else
__device__ __forceinline__ void st16_wt(void* p, u32x4 v) { *(u32x4*)p = v; }
#endif
template <int ACT> struct EpiBf16 {
    static constexpr bool PERM = true, AFTER_DRAIN = false;
    bf16_t* O; int ldc;
    __device__ __forceinline__ void operator()(const f32x4 (&acc)[2][2][4][2], const Unit& u, int wr, int wc, int fr, int fq) const {
        const int row0 = u.pm * BM + wr * 64 + fr; const int col0 = u.pn * BM + wc * 32 + 8 * fq;
#pragma unroll
        for (int ai = 0; ai < 2; ++ai)
#pragma unroll
            for (int m = 0; m < 4; ++m) { bf16_t* rowp = O + (size_t)(row0 + ai * HALF + m * 16) * ldc + col0;
#pragma unroll
                for (int bj = 0; bj < 2; ++bj) { const f32x4 v0 = acc[ai][bj][m][0], v1 = acc[ai][bj][m][1];
                    u32x4 w; w.x = cvt_pk_bf16(v0[0], v0[1]); w.y = cvt_pk_bf16(v0[2], v0[3]); w.z = cvt_pk_bf16(v1[0], v1[1]); w.w = cvt_pk_bf16(v1[2], v1[3]);
                    __builtin_nontemporal_store(w, (u32x4*)(rowp + bj * HALF)); } }
    }
};
struct EpiInProj {
    static constexpr bool PERM = true, AFTER_DRAIN = false;
    bf16_t* P; float* G;
    __device__ __forceinline__ void operator()(const f32x4 (&acc)[2][2][4][2], const Unit& u, int wr, int wc, int fr, int fq) const {
        const int row0 = u.pm * BM + wr * 64 + fr; const int pn = u.pn;
        if (pn == 18) {
            if (wc == 0 && fq < 2) {
#pragma unroll
                for (int ai = 0; ai < 2; ++ai)
#pragma unroll
                    for (int m = 0; m < 4; ++m) { float* gp = G + (size_t)(row0 + ai * HALF + m * 16) * 16 + 8 * fq;
                        *(f32x4*)(gp) = acc[ai][0][m][0]; *(f32x4*)(gp + 4) = acc[ai][0][m][1]; }
            }
            return;
        }
        const int col0 = pn * BM + wc * 32 + 8 * fq;
        const int mode = (pn == 8 || pn == 9) ? 1 : (pn >= 14 ? 2 : 0);
#pragma unroll
        for (int ai = 0; ai < 2; ++ai)
#pragma unroll
            for (int m = 0; m < 4; ++m) { bf16_t* rowp = P + (size_t)(row0 + ai * HALF + m * 16) * 4608 + col0;
#pragma unroll
                for (int bj = 0; bj < 2; ++bj) { f32x4 v0 = acc[ai][bj][m][0], v1 = acc[ai][bj][m][1];
                    if (mode == 1) { v0 = v0 * 0.08838834764831845f; v1 = v1 * 0.08838834764831845f; }
                    else if (mode == 2) {
#pragma unroll
                        for (int j = 0; j < 4; ++j) { v0[j] = __builtin_amdgcn_rcpf(1.0f + __builtin_amdgcn_exp2f(-1.4426950408889634f * v0[j])); v1[j] = __builtin_amdgcn_rcpf(1.0f + __builtin_amdgcn_exp2f(-1.4426950408889634f * v1[j])); } }
                    u32x4 w; w.x = cvt_pk_bf16(v0[0], v0[1]); w.y = cvt_pk_bf16(v0[2], v0[3]); w.z = cvt_pk_bf16(v1[0], v1[1]); w.w = cvt_pk_bf16(v1[2], v1[3]);
                    *(u32x4*)(rowp + bj * HALF) = w; } }
    }
};
struct EpiResid {
    static constexpr bool PERM = false, AFTER_DRAIN = false;
    const float* base; float* out; const float* gate;
    __device__ __forceinline__ void operator()(const f32x4 (&acc)[2][2][4][2], const Unit& u, int wr, int wc, int fr, int fq) const {
        const int row0 = u.pm * BM + wr * 64 + fr; const int col0 = u.pn * BM + wc * 32 + 4 * fq;
#pragma unroll
        for (int bj = 0; bj < 2; ++bj)
#pragma unroll
            for (int n = 0; n < 2; ++n) { const f32x4 g = *(const f32x4*)(gate + col0 + bj * HALF + n * 16);
#pragma unroll
                for (int ai = 0; ai < 2; ++ai)
#pragma unroll
                    for (int m = 0; m < 4; ++m) { const size_t off = (size_t)(row0 + ai * HALF + m * 16) * 2048 + col0 + bj * HALF + n * 16;
                        const f32x4 b = *(const f32x4*)(base + off); { const f32x4 o_ = b + g * acc[ai][bj][m][n]; st16_wt(out + off, __builtin_bit_cast(u32x4, o_)); } } }
    }
};
struct RowStats {
    float* slots;
    unsigned* cnt;
    __device__ __forceinline__ void run(const f32x4 (&v)[2][2][4][2], const Unit& u, int wr, int wc, int fr, int fq, PG8_LAS unsigned char* lds, int wid, int lane) const {
        PG8_LAS float* Pp = (PG8_LAS float*)lds;
        PG8_LAS float* S = (PG8_LAS float*)(lds + 4096);
#pragma unroll
        for (int ai = 0; ai < 2; ++ai)
#pragma unroll
            for (int m = 0; m < 4; ++m) { float s = 0.f;
#pragma unroll
                for (int bj = 0; bj < 2; ++bj)
#pragma unroll
                    for (int n = 0; n < 2; ++n) { const f32x4 x = v[ai][bj][m][n]; s += (x[0] * x[0] + x[1] * x[1]) + (x[2] * x[2] + x[3] * x[3]); }
                s += __shfl_xor(s, 16); s += __shfl_xor(s, 32);
                if (fq == 0) Pp[(ai * HALF + wr * 64 + m * 16 + fr) * 4 + wc] = s; }
        asm volatile("s_waitcnt lgkmcnt(0)" ::: "memory"); __builtin_amdgcn_s_barrier(); asm volatile("" ::: "memory");
        const int row = wid * 32 + (lane & 31);
        if (lane < 32) { const float tot = (Pp[row * 4 + 0] + Pp[row * 4 + 1]) + (Pp[row * 4 + 2] + Pp[row * 4 + 3]);
            __hip_atomic_store(slots + (size_t)(u.pm * BM + row) * 8 + u.pn, tot, __ATOMIC_RELAXED, __HIP_MEMORY_SCOPE_AGENT); }
        asm volatile("s_waitcnt vmcnt(0)" ::: "memory");
        if (lane == 0) __hip_atomic_fetch_add(cnt + 64 * u.pm, 1u, __ATOMIC_RELAXED, __HIP_MEMORY_SCOPE_AGENT);
        if (wid == 0) { unsigned sp = 0;
            for (;;) { if ((unsigned)__builtin_amdgcn_readfirstlane(__hip_atomic_load(cnt + 64 * u.pm, __ATOMIC_RELAXED, __HIP_MEMORY_SCOPE_AGENT)) >= 64u) break;
                __builtin_amdgcn_s_sleep(2); if (++sp > (1u << 22)) break; }
            __builtin_amdgcn_fence(__ATOMIC_ACQUIRE, "agent"); }
        asm volatile("s_waitcnt vmcnt(0) lgkmcnt(0)" ::: "memory"); __builtin_amdgcn_s_barrier(); asm volatile("" ::: "memory");
        if (lane < 32) { const float* sl = slots + (size_t)(u.pm * BM + row) * 8; float q = 0.f;
#pragma unroll
            for (int t = 0; t < 8; ++t) q += __hip_atomic_load(sl + t, __ATOMIC_RELAXED, __HIP_MEMORY_SCOPE_AGENT);
            S[row] = rsqrtf(q * (1.0f / 2048.0f) + 1e-6f); }
        asm volatile("s_waitcnt lgkmcnt(0)" ::: "memory"); __builtin_amdgcn_s_barrier(); asm volatile("" ::: "memory");
    }
};
struct EpiResidNorm {
    static constexpr bool PERM = false, AFTER_DRAIN = true;
    const float* base; float* out; const float* gate; const float* gain; RowStats st;
    __device__ __forceinline__ void operator()(const f32x4 (&)[2][2][4][2], const Unit&, int, int, int, int) const {}
    __device__ __forceinline__ void fused(f32x4 (&acc)[2][2][4][2], const Unit& u, int wr, int wc, int fr, int fq, PG8_LAS unsigned char* lds, int wid, int lane) const {
        const int row0 = u.pm * BM + wr * 64 + fr; const int col0 = u.pn * BM + wc * 32 + 4 * fq; size_t off0 = (size_t)row0 * 2048 + col0;
#pragma unroll
        for (int bj = 0; bj < 2; ++bj)
#pragma unroll
            for (int n = 0; n < 2; ++n) { const f32x4 g = *(const f32x4*)(gate + col0 + bj * HALF + n * 16);
#pragma unroll
                for (int ai = 0; ai < 2; ++ai)
#pragma unroll
                    for (int m = 0; m < 4; ++m) { const size_t off = off0 + (size_t)((ai * HALF + m * 16) * 2048 + bj * HALF + n * 16);
                        acc[ai][bj][m][n] = __builtin_nontemporal_load((const f32x4*)(base + off)) + g * acc[ai][bj][m][n];
                        asm volatile("" : "+v"(acc[ai][bj][m][n]));
                        if (m == 3) asm volatile("" ::: "memory"); } }
        st.run(acc, u, wr, wc, fr, fq, lds, wid, lane);
        asm volatile("" : "+v"(off0));
        const PG8_LAS float* S = (const PG8_LAS float*)(lds + 4096);
#pragma unroll
        for (int bj = 0; bj < 2; ++bj)
#pragma unroll
            for (int n = 0; n < 2; ++n) { const f32x4 gn = *(const f32x4*)(gain + col0 + bj * HALF + n * 16);
#pragma unroll
                for (int ai = 0; ai < 2; ++ai)
#pragma unroll
                    for (int m = 0; m < 4; ++m) { const int r = ai * HALF + wr * 64 + m * 16 + fr; const size_t off = off0 + (size_t)((ai * HALF + m * 16) * 2048 + bj * HALF + n * 16);
                        { const f32x4 o_ = acc[ai][bj][m][n] * S[r] * gn; __builtin_nontemporal_store(o_, (f32x4*)(out + off)); } }
                asm volatile("" ::: "memory"); }
    }
};
struct EpiResidNormMod {
    static constexpr bool PERM = false, AFTER_DRAIN = true;
    const float* base; float* out; const float* gate; const float* gain; const float* sh; const float* sc; bf16_t* hn; RowStats st;
    __device__ __forceinline__ void operator()(const f32x4 (&)[2][2][4][2], const Unit&, int, int, int, int) const {}
    __device__ __forceinline__ void fused(f32x4 (&acc)[2][2][4][2], const Unit& u, int wr, int wc, int fr, int fq, PG8_LAS unsigned char* lds, int wid, int lane) const {
        typedef unsigned u32x2_ __attribute__((ext_vector_type(2)));
        const int row0 = u.pm * BM + wr * 64 + fr; const int col0 = u.pn * BM + wc * 32 + 4 * fq; size_t off0 = (size_t)row0 * 2048 + col0;
#pragma unroll
        for (int bj = 0; bj < 2; ++bj)
#pragma unroll
            for (int n = 0; n < 2; ++n) { const f32x4 g = *(const f32x4*)(gate + col0 + bj * HALF + n * 16);
#pragma unroll
                for (int ai = 0; ai < 2; ++ai)
#pragma unroll
                    for (int m = 0; m < 4; ++m) { const size_t off = off0 + (size_t)((ai * HALF + m * 16) * 2048 + bj * HALF + n * 16);
                        const f32x4 x1 = __builtin_nontemporal_load((const f32x4*)(base + off)) + g * acc[ai][bj][m][n]; acc[ai][bj][m][n] = x1; __builtin_nontemporal_store(x1, (f32x4*)(out + off));
                        asm volatile("" : "+v"(acc[ai][bj][m][n]));
                        if (m == 3) asm volatile("" ::: "memory"); } }
        st.run(acc, u, wr, wc, fr, fq, lds, wid, lane);
        asm volatile("" : "+v"(off0));
        const PG8_LAS float* S = (const PG8_LAS float*)(lds + 4096);
#pragma unroll
        for (int bj = 0; bj < 2; ++bj)
#pragma unroll
            for (int n = 0; n < 2; ++n) { const int c = col0 + bj * HALF + n * 16; const f32x4 gn = *(const f32x4*)(gain + c), s1 = *(const f32x4*)(sc + c) + 1.0f, s0 = *(const f32x4*)(sh + c);
#pragma unroll
                for (int ai = 0; ai < 2; ++ai)
#pragma unroll
                    for (int m = 0; m < 4; ++m) { const int r = ai * HALF + wr * 64 + m * 16 + fr; const size_t off = off0 + (size_t)((ai * HALF + m * 16) * 2048 + bj * HALF + n * 16);
                        const f32x4 y = (acc[ai][bj][m][n] * S[r] * gn) * s1 + s0; u32x2_ w; w.x = cvt_pk_bf16(y[0], y[1]); w.y = cvt_pk_bf16(y[2], y[3]); *(u32x2_*)(hn + off) = w; }
                asm volatile("" ::: "memory"); }
    }
};
template <class Epi, class Sched, bool ALIGN_EPI = false, bool SP2 = false>
__device__ __forceinline__ void gemm_phase(PG8_LAS unsigned char* lds, const Gemm g, const Sched& S, const Epi& E) {
    const int tid = ltid(), wid = __builtin_amdgcn_readfirstlane(tid >> 6), lane = tid & 63, wr = wid >> 2, wc = wid & 3, fr = lane & 15, fq = lane >> 4;
    const int K = g.K, nt = K / BK;
    unsigned voffA[2], voffB[2];
#pragma unroll
    for (int i = 0; i < 2; ++i) { int R, C; stage_rc(tid * 16 + i * 8192, R, C); const int Rb = Epi::PERM ? ((R & ~31) + perm32(R & 31)) : R;
        voffA[i] = (unsigned)(R * K + C) * 2u; voffB[i] = (unsigned)(Rb * K + C) * 2u; }
    const size_t kstep = (size_t)(BK * 2);
    const size_t hstep = (size_t)HALF * K * 2;
    const size_t tstep = 2 * hstep; const size_t tstepA = (size_t)g.a_rows * K * 2;
    const unsigned ldsw = (unsigned)wid * 1024u;
    const int aoff = lds_byte(wr * 64 + fr, fq * 8), boff = lds_byte(wc * 32 + fr, fq * 8);
#define PG8_SA(b, h) (((b) * 2 + (h)) * HTB)
#define PG8_SB(b, h) ((4 + (b) * 2 + (h)) * HTB)
#define PG8_STAGE(bufoff, gbase, voff) do { _Pragma("unroll") for (int _i = 0; _i < 2; ++_i) \
        __builtin_amdgcn_global_load_lds((const unsigned*)((const char*)(gbase) + (voff)[_i]), (PG8_LAS unsigned*)(lds + (bufoff) + ldsw + _i * 8192), 16, 0, 0); } while (0)
#define PG8_LDA(dst, b, h) do { _Pragma("unroll") for (int m = 0; m < 4; ++m) _Pragma("unroll") for (int k = 0; k < 2; ++k) dst[m][k] = *(const PG8_LAS bf16x8*)(lds + PG8_SA(b, h) + aoff + m * 2048 + k * 1024); } while (0)
#define PG8_LDB(dst, b, h) do { _Pragma("unroll") for (int n = 0; n < 2; ++n) _Pragma("unroll") for (int k = 0; k < 2; ++k) dst[n][k] = *(const PG8_LAS bf16x8*)(lds + PG8_SB(b, h) + boff + n * 2048 + k * 1024); } while (0)
#define PG8_MMA(ai, bj, At, Bt) do { __builtin_amdgcn_s_setprio(1); _Pragma("unroll") for (int m = 0; m < 4; ++m) _Pragma("unroll") for (int n = 0; n < 2; ++n) _Pragma("unroll") for (int k = 0; k < 2; ++k) \
        acc[ai][bj][m][n] = __builtin_amdgcn_mfma_f32_16x16x32_bf16(Bt[n][k], At[m][k], acc[ai][bj][m][n], 0, 0, 0); __builtin_amdgcn_s_setprio(0); } while (0)
#define PG8_WAIT_V(n) asm volatile("s_waitcnt vmcnt(" #n ")" ::: "memory")
#define PG8_WAIT_L(n) asm volatile("s_waitcnt lgkmcnt(" #n ")" ::: "memory")
#define PG8_BAR __builtin_amdgcn_s_barrier()
#define PG8_SCHED __builtin_amdgcn_sched_barrier(0)
    Unit cur, nxt; int ui = 0;
    if (!S.next(0, cur)) return;
    f32x4 acc[2][2][4][2];
#pragma unroll
    for (int a = 0; a < 2; ++a)
#pragma unroll
        for (int b = 0; b < 2; ++b)
#pragma unroll
            for (int m = 0; m < 4; ++m)
#pragma unroll
                for (int n = 0; n < 2; ++n) acc[a][b][m][n] = (f32x4){0.f, 0.f, 0.f, 0.f};
    bf16x8 At[4][2], B0[2][2], B1[2][2];
    const char* cA = (const char*)g.A + (size_t)cur.pm * tstepA; const char* cB = (const char*)g.Bt + (size_t)cur.pn * tstep;
    S.a_ready(cur);
    if constexpr (SP2) {
        PG8_STAGE(PG8_SB(0, 0), cB, voffB); PG8_STAGE(PG8_SB(0, 1), cB + hstep, voffB); PG8_STAGE(PG8_SA(0, 0), cA, voffA); PG8_STAGE(PG8_SA(0, 1), cA + hstep, voffA);
        if (wr == 1) PG8_BAR;
        PG8_WAIT_V(2); PG8_BAR;
        PG8_STAGE(PG8_SB(1, 0), cB + kstep, voffB); PG8_STAGE(PG8_SA(1, 0), cA + kstep, voffA); PG8_STAGE(PG8_SB(1, 1), cB + hstep + kstep, voffB);
        PG8_WAIT_V(6); PG8_BAR;
    } else {
        PG8_STAGE(PG8_SB(0, 0), cB, voffB); PG8_STAGE(PG8_SA(0, 0), cA, voffA); PG8_STAGE(PG8_SB(0, 1), cB + hstep, voffB); PG8_STAGE(PG8_SA(0, 1), cA + hstep, voffA);
        if (wr == 1) PG8_BAR;
        PG8_WAIT_V(4); PG8_BAR;
        PG8_STAGE(PG8_SB(1, 0), cB + kstep, voffB); PG8_STAGE(PG8_SA(1, 0), cA + kstep, voffA); PG8_STAGE(PG8_SB(1, 1), cB + hstep + kstep, voffB);
        PG8_WAIT_V(6); PG8_BAR;
    }
    for (;;) {
        const bool has_next = S.next(ui + 1, nxt);
        const char* nA = has_next ? (const char*)g.A + (size_t)nxt.pm * tstepA : cA; const char* nB = has_next ? (const char*)g.Bt + (size_t)nxt.pn * tstep : cB;
        for (int t = 0; t < nt; t += 2) {
            const bool last = (t == nt - 2);
            const char* a1 = cA + (size_t)(t + 1) * kstep;
            const char* a2 = last ? nA : cA + (size_t)(t + 2) * kstep; const char* b2 = last ? nB : cB + (size_t)(t + 2) * kstep;
            const char* a3 = a2 + kstep; const char* b3 = b2 + kstep;
            if (last && has_next) S.a_ready(nxt);
            if constexpr (SP2) {
            PG8_LDB(B0, 0, 0); PG8_LDB(B1, 0, 1); PG8_SCHED; PG8_LDA(At, 0, 0); PG8_STAGE(PG8_SA(1, 1), a1 + hstep, voffA);
            PG8_WAIT_V(8); PG8_WAIT_L(0); PG8_BAR; PG8_MMA(0, 0, At, B0); PG8_MMA(0, 1, At, B1); PG8_BAR; PG8_SCHED;
            PG8_LDA(At, 0, 1); PG8_STAGE(PG8_SB(0, 0), b2, voffB); PG8_STAGE(PG8_SB(0, 1), b2 + hstep, voffB); PG8_STAGE(PG8_SA(0, 0), a2, voffA);
            PG8_WAIT_V(8); PG8_WAIT_L(0); PG8_BAR; PG8_MMA(1, 0, At, B0); PG8_MMA(1, 1, At, B1); PG8_BAR; PG8_SCHED;
            PG8_LDB(B0, 1, 0); PG8_LDB(B1, 1, 1); PG8_SCHED; PG8_LDA(At, 1, 0); PG8_STAGE(PG8_SA(0, 1), a2 + hstep, voffA);
            PG8_WAIT_V(8); PG8_WAIT_L(0); PG8_BAR; PG8_MMA(0, 0, At, B0); PG8_MMA(0, 1, At, B1); PG8_BAR; PG8_SCHED;
            PG8_LDA(At, 1, 1); PG8_STAGE(PG8_SB(1, 0), b3, voffB); PG8_STAGE(PG8_SB(1, 1), b3 + hstep, voffB); PG8_STAGE(PG8_SA(1, 0), a3, voffA);
            PG8_WAIT_V(8); PG8_WAIT_L(0); PG8_BAR; PG8_MMA(1, 0, At, B0); PG8_MMA(1, 1, At, B1); PG8_BAR; PG8_SCHED;
            } else {
            PG8_LDB(B0, 0, 0); PG8_SCHED; PG8_LDA(At, 0, 0); PG8_STAGE(PG8_SA(1, 1), a1 + hstep, voffA);
            PG8_WAIT_L(8); PG8_BAR; PG8_WAIT_L(0); PG8_MMA(0, 0, At, B0); PG8_BAR; PG8_SCHED;
            PG8_LDB(B1, 0, 1); PG8_STAGE(PG8_SB(0, 0), b2, voffB);
            PG8_BAR; PG8_WAIT_L(0); PG8_MMA(0, 1, At, B1); PG8_BAR;
            PG8_LDA(At, 0, 1); PG8_STAGE(PG8_SA(0, 0), a2, voffA);
            PG8_BAR; PG8_WAIT_L(0); PG8_MMA(1, 0, At, B0); PG8_BAR; PG8_SCHED;
            PG8_STAGE(PG8_SB(0, 1), b2 + hstep, voffB);
            PG8_WAIT_V(6); PG8_BAR; PG8_MMA(1, 1, At, B1); PG8_BAR;
            PG8_LDB(B0, 1, 0); PG8_SCHED; PG8_LDA(At, 1, 0); PG8_STAGE(PG8_SA(0, 1), a2 + hstep, voffA);
            PG8_WAIT_L(8); PG8_BAR; PG8_WAIT_L(0); PG8_MMA(0, 0, At, B0); PG8_BAR; PG8_SCHED;
            PG8_LDB(B1, 1, 1); PG8_STAGE(PG8_SB(1, 0), b3, voffB);
            PG8_BAR; PG8_WAIT_L(0); PG8_MMA(0, 1, At, B1); PG8_BAR;
            PG8_LDA(At, 1, 1); PG8_STAGE(PG8_SA(1, 0), a3, voffA);
            PG8_BAR; PG8_WAIT_L(0); PG8_MMA(1, 0, At, B0); PG8_BAR; PG8_SCHED;
            PG8_STAGE(PG8_SB(1, 1), b3 + hstep, voffB);
            PG8_WAIT_V(6); PG8_BAR; PG8_MMA(1, 1, At, B1); PG8_BAR;
            }
        }
        if constexpr (ALIGN_EPI) { if (wr == 0) PG8_BAR; }
        if constexpr (!Epi::AFTER_DRAIN) { E(acc, cur, wr, wc, fr, fq); S.done(cur); }
        if (!has_next) break;
#pragma unroll
        for (int a = 0; a < 2; ++a)
#pragma unroll
            for (int b = 0; b < 2; ++b)
#pragma unroll
                for (int m = 0; m < 4; ++m)
#pragma unroll
                    for (int n = 0; n < 2; ++n) acc[a][b][m][n] = (f32x4){0.f, 0.f, 0.f, 0.f};
        cur = nxt; cA = nA; cB = nB; ++ui;
        if constexpr (ALIGN_EPI) { if (wr == 1) PG8_BAR; }
    }
    PG8_WAIT_V(0);
    if constexpr (!ALIGN_EPI) { if (wr == 0) PG8_BAR; }
    PG8_BAR;
    if constexpr (Epi::AFTER_DRAIN) { E.fused(acc, cur, wr, wc, fr, fq, lds, wid, lane); S.done(cur); }
#undef PG8_SA
#undef PG8_SB
#undef PG8_STAGE
#undef PG8_LDA
#undef PG8_LDB
#undef PG8_MMA
#undef PG8_WAIT_V
#undef PG8_WAIT_L
#undef PG8_BAR
#undef PG8_SCHED
}
}
namespace att {
typedef unsigned short bf16;
constexpr int   D = 128, NW = 8, QBLK = 32, KVBLK = 64;
constexpr float SCALE = 0.088388347648318440f;
constexpr float THR = 8.f;
constexpr int LDQ = 4608, LDK = 4608, LDO = 2048;
constexpr size_t SHM_V = KVBLK * D * 2, SHM_K = KVBLK * D * 2, SHM_ATTN = 2 * SHM_V + 2 * SHM_K + NW * 64 * 4;
using bf16x8 = __attribute__((ext_vector_type(8))) short;
using s16x4  = __attribute__((ext_vector_type(4))) short;
using f32x16 = __attribute__((ext_vector_type(16))) float;
using u32x4  = __attribute__((ext_vector_type(4))) unsigned;
#define KSWZ(row, colB) ((row) * 256 + ((colB) ^ (((row) & 7) << 4)))
#define SBAR() __builtin_amdgcn_sched_barrier(0)
__device__ __forceinline__ int crow(int r, int hi) { return (r & 3) + 8 * (r >> 2) + 4 * hi; }
__device__ __forceinline__ unsigned cvtpk(float lo, float hi) {
  unsigned r; asm volatile("v_cvt_pk_bf16_f32 %0, %1, %2" : "=v"(r) : "v"(lo), "v"(hi)); return r;
}
__device__ __forceinline__ bf16x8 ld8(const bf16* p) { return *reinterpret_cast<const bf16x8*>(p); }
__device__ __forceinline__ void partialSM(f32x16& p0, f32x16& p1, float& m_reg, float& mn, float& alpha) {
  constexpr float C = SCALE * 1.4426950408889634f;
  float pmax = p0[0]; for (int r = 1; r < 16; ++r) pmax = fmaxf(pmax, p0[r]); for (int r = 0; r < 16; ++r) pmax = fmaxf(pmax, p1[r]);
  { auto rr = __builtin_amdgcn_permlane32_swap(__float_as_uint(pmax), __float_as_uint(pmax), false, false);
    pmax = fmaxf(__uint_as_float(rr[0]), __uint_as_float(rr[1])); }
  if (__builtin_expect(__all(pmax - m_reg <= THR / SCALE), 1)) { mn = m_reg; alpha = 1.f; }
  else { mn = fmaxf(m_reg, pmax); alpha = __builtin_amdgcn_exp2f((m_reg - mn) * C); m_reg = mn; }
  float mnC = -mn * C;
  for (int r = 0; r < 16; ++r) p0[r] = fmaf(p0[r], C, mnC); for (int r = 0; r < 16; ++r) p1[r] = fmaf(p1[r], C, mnC);
  for (int r = 0; r < 16; ++r) p0[r] = __builtin_amdgcn_exp2f(p0[r]);
}
#define PK4(P, BASE, OUT) do { unsigned a0 = cvtpk(P[BASE + 0], P[BASE + 1]), a1 = cvtpk(P[BASE + 2], P[BASE + 3]);   \
    unsigned b0 = cvtpk(P[BASE + 4], P[BASE + 5]), b1 = cvtpk(P[BASE + 6], P[BASE + 7]);                              \
    auto r0 = __builtin_amdgcn_permlane32_swap(a0, b0, false, false); auto r1 = __builtin_amdgcn_permlane32_swap(a1, b1, false, false); \
    u32x4 w = {r0[0], r1[0], r0[1], r1[1]}; OUT = *reinterpret_cast<bf16x8*>(&w); } while (0)
__device__ __forceinline__ void finishSM(f32x16& p0, f32x16& p1, float alpha, float& l_reg, bf16x8& pa0, bf16x8& pa1, bf16x8& pa2, bf16x8& pa3) {
  for (int r = 0; r < 16; ++r) p1[r] = __builtin_amdgcn_exp2f(p1[r]);
  float ps = 0; for (int r = 0; r < 16; ++r) ps += p0[r]; for (int r = 0; r < 16; ++r) ps += p1[r];
  { auto rr = __builtin_amdgcn_permlane32_swap(__float_as_uint(ps), __float_as_uint(ps), false, false);
    ps = __uint_as_float(rr[0]) + __uint_as_float(rr[1]); }
  l_reg = l_reg * alpha + ps;
  PK4(p0, 0, pa0); PK4(p0, 8, pa1); PK4(p1, 0, pa2); PK4(p1, 8, pa3);
}
__device__ __forceinline__ void qkt(f32x16& p0, f32x16& p1, const bf16* Ks, const bf16x8* qr, int r32, int hi) {
  p0 = f32x16{}; p1 = f32x16{};
  for (int d0 = 0; d0 < 8; ++d0) { int cb = (d0 * 16 + hi * 8) * 2;
    bf16x8 b0 = *reinterpret_cast<const bf16x8*>((const char*)Ks + KSWZ(r32, cb));
    bf16x8 b1 = *reinterpret_cast<const bf16x8*>((const char*)Ks + KSWZ(32 + r32, cb));
    p0 = __builtin_amdgcn_mfma_f32_32x32x16_bf16(b0, qr[d0], p0, 0, 0, 0);
    p1 = __builtin_amdgcn_mfma_f32_32x32x16_bf16(b1, qr[d0], p1, 0, 0, 0); }
}
__device__ __forceinline__ int v_st(int k, int c) { const int kk = (k & ~0xC) | ((k & 4) << 1) | ((k & 8) >> 1); return ((kk >> 3) * 4 + (c >> 5)) * 512 + ((kk & 7) * 32 + (c & 31)) * 2; }
__device__ __forceinline__ int v_rd_base(int lane) { return ((lane & 3) << 3) | (((lane >> 2) & 3) << 6) | (((lane >> 4) & 1) << 5) | (((lane >> 5) & 1) << 8); }
constexpr int v_rd_off(int d0, int ks, int half) { return d0 * 512 + ks * 4096 + half * 2048; }
template <int OFF> __device__ __forceinline__ s16x4 tr_read(int vb) {
  s16x4 r; asm volatile("ds_read_b64_tr_b16 %0, %1 offset:%2" : "=&v"(r) : "v"(vb), "i"(OFF) : "memory"); return r;
}
template <int D0> __device__ __forceinline__ void pv_one(f32x16& od, int vb, bf16x8 pa0, bf16x8 pa1, bf16x8 pa2, bf16x8 pa3) {
  const s16x4 l0 = tr_read<v_rd_off(D0, 0, 0)>(vb), h0 = tr_read<v_rd_off(D0, 0, 1)>(vb), l1 = tr_read<v_rd_off(D0, 1, 0)>(vb), h1 = tr_read<v_rd_off(D0, 1, 1)>(vb);
  const s16x4 l2 = tr_read<v_rd_off(D0, 2, 0)>(vb), h2 = tr_read<v_rd_off(D0, 2, 1)>(vb), l3 = tr_read<v_rd_off(D0, 3, 0)>(vb), h3 = tr_read<v_rd_off(D0, 3, 1)>(vb);
  asm volatile("s_waitcnt lgkmcnt(0)" ::: "memory"); SBAR();
#define PK(L, H) (bf16x8){L[0], L[1], L[2], L[3], H[0], H[1], H[2], H[3]}
  od = __builtin_amdgcn_mfma_f32_32x32x16_bf16(pa0, PK(l0, h0), od, 0, 0, 0);
  od = __builtin_amdgcn_mfma_f32_32x32x16_bf16(pa1, PK(l1, h1), od, 0, 0, 0);
  od = __builtin_amdgcn_mfma_f32_32x32x16_bf16(pa2, PK(l2, h2), od, 0, 0, 0);
  od = __builtin_amdgcn_mfma_f32_32x32x16_bf16(pa3, PK(l3, h3), od, 0, 0, 0);
#undef PK
}
__device__ __forceinline__ void pv_d0(f32x16* o, int vb, bf16x8 pa0, bf16x8 pa1, bf16x8 pa2, bf16x8 pa3) {
  pv_one<0>(o[0], vb, pa0, pa1, pa2, pa3); pv_one<1>(o[1], vb, pa0, pa1, pa2, pa3); pv_one<2>(o[2], vb, pa0, pa1, pa2, pa3); pv_one<3>(o[3], vb, pa0, pa1, pa2, pa3);
}
__device__ __forceinline__ void attn_dense_body(const bf16* __restrict__ Qb, const bf16* __restrict__ Kh, const bf16* __restrict__ Vh,
                                                bf16* __restrict__ Ob, int seq, char* lds) {
  const int tid = ltid(), wid = tid >> 6, lane = tid & 63, r32 = lane & 31, hi = lane >> 5;
  bf16* V_lds = (bf16*)lds; bf16* K_lds = (bf16*)(lds + 2 * SHM_V);
  float* ws = (float*)(lds + 2 * SHM_V + 2 * SHM_K) + wid * 64; float* li_l = ws; float* al_l = ws + 32;
  float m_reg = -1e30f, l_reg = 0; f32x16 o[4] = {}; bf16x8 qr[8];
  const bf16* Qw = Qb + (long)(wid * QBLK + r32) * LDQ + hi * 8;
#pragma unroll
  for (int d0 = 0; d0 < 8; ++d0) qr[d0] = ld8(Qw + d0 * 16);
  const int sr = tid >> 4, sc = (tid & 15) * 8, vst0 = v_st(sr, sc), vst1 = v_st(32 + sr, sc);
  const int vb0 = (int)(uintptr_t)V_lds + v_rd_base(lane);
  struct { bf16x8 vs0, vs1, ks0, ks1; } sr_[1];
#define SLOAD(i, k0) do { sr_[i].vs0 = ld8(&Vh[(long)((k0) + sr) * LDK + sc]); sr_[i].vs1 = ld8(&Vh[(long)((k0) + 32 + sr) * LDK + sc]); \
    sr_[i].ks0 = ld8(&Kh[(long)((k0) + sr) * LDK + sc]); sr_[i].ks1 = ld8(&Kh[(long)((k0) + 32 + sr) * LDK + sc]); } while (0)
#define SWRITE(b, i) do { *(bf16x8*)((char*)V_lds + (b) * SHM_V + vst0) = sr_[i].vs0;          \
    *(bf16x8*)((char*)V_lds + (b) * SHM_V + vst1) = sr_[i].vs1; int kc = sc * 2;               \
    *(bf16x8*)((char*)K_lds + (b) * SHM_K + KSWZ(sr, kc)) = sr_[i].ks0;                       \
    *(bf16x8*)((char*)K_lds + (b) * SHM_K + KSWZ(32 + sr, kc)) = sr_[i].ks1; } while (0)
#define SWAIT() do { asm volatile("s_waitcnt vmcnt(0)" ::: "memory"); } while (0)
#define RESC(a) do { if (__any((a) < 1.f)) { if (hi == 0) al_l[r32] = (a); asm volatile("s_waitcnt lgkmcnt(0)" ::: "memory"); \
    for (int d = 0; d < 4; ++d) for (int r = 0; r < 16; ++r) o[d][r] *= al_l[crow(r, hi)]; } } while (0)
  f32x16 pA0, pA1, pB0, pB1; float mnA, mnB, alA, alB; bf16x8 pa0, pa1, pa2, pa3; const int NT = seq / KVBLK;
  constexpr int SE = 0, SO = 0;
  SLOAD(SE, 0); asm volatile("s_waitcnt vmcnt(0)" ::: "memory"); SWRITE(0, SE); __syncthreads();
  qkt(pA0, pA1, K_lds, qr, r32, hi); partialSM(pA0, pA1, m_reg, mnA, alA);
  SLOAD(SO, KVBLK);
  SWAIT(); SWRITE(1, SO); __syncthreads();
  for (int j = 1; j + 1 < NT; j += 2) {
    SBAR(); qkt(pB0, pB1, (bf16*)((char*)K_lds + SHM_K), qr, r32, hi);
    finishSM(pA0, pA1, alA, l_reg, pa0, pa1, pa2, pa3); SBAR();
    SLOAD(SO, (j + 1) * KVBLK); SBAR();
    pv_d0(o, vb0, pa0, pa1, pa2, pa3); partialSM(pB0, pB1, m_reg, mnB, alB);
    __syncthreads(); SWAIT(); SWRITE(0, SE);
    RESC(alB); __syncthreads();
    SBAR(); qkt(pA0, pA1, K_lds, qr, r32, hi);
    finishSM(pB0, pB1, alB, l_reg, pa0, pa1, pa2, pa3); SBAR();
    SLOAD(SE, (j + 2) * KVBLK); SBAR();
    pv_d0(o, vb0 + (int)SHM_V, pa0, pa1, pa2, pa3); partialSM(pA0, pA1, m_reg, mnA, alA);
    __syncthreads(); SWAIT(); SWRITE(1, SO);
    RESC(alA); __syncthreads();
  }
  SBAR(); qkt(pB0, pB1, (bf16*)((char*)K_lds + SHM_K), qr, r32, hi);
  finishSM(pA0, pA1, alA, l_reg, pa0, pa1, pa2, pa3); SBAR();
  pv_d0(o, vb0, pa0, pa1, pa2, pa3); partialSM(pB0, pB1, m_reg, mnB, alB);
  __syncthreads(); RESC(alB);
  finishSM(pB0, pB1, alB, l_reg, pa0, pa1, pa2, pa3); SBAR();
  pv_d0(o, vb0 + (int)SHM_V, pa0, pa1, pa2, pa3);
  if (hi == 0) li_l[r32] = l_reg; asm volatile("s_waitcnt lgkmcnt(0)" ::: "memory");
  float rli[16];
#pragma unroll
  for (int r = 0; r < 16; ++r) rli[r] = __builtin_amdgcn_rcpf(li_l[crow(r, hi)]);
  bf16* Ow = Ob + (long)(wid * QBLK) * LDO;
#pragma unroll
  for (int r = 0; r < 16; ++r) { int orow = crow(r, hi);
    for (int d0 = 0; d0 < 4; ++d0) { const float v = o[d0][r] * rli[r]; Ow[(long)orow * LDO + d0 * 32 + r32] = (bf16)(cvtpk(v, v) & 0xffffu); } }
#undef SLOAD
#undef SWRITE
#undef SWAIT
#undef RESC
}
}
#define LAS __attribute__((address_space(3)))
#define XB_TMO      128
#define XB_XCNT(j)  (256  + 64 * (j))
#define XB_XSUB(j)  (1280 + 64 * (j))
#define XB_XGEN(j)  (2304 + 64 * (j))
#define XB_TOP      3328
#define XB_TOPGEN   3392
#define XCD_BAR_WORDS 3456
#define XB_SPIN_CAP (1u << 18)

__device__ __forceinline__ unsigned xb_ld(unsigned* p)              { return __hip_atomic_load(p, __ATOMIC_RELAXED, __HIP_MEMORY_SCOPE_AGENT); }
__device__ __forceinline__ unsigned xb_add(unsigned* p, unsigned v) { return __hip_atomic_fetch_add(p, v, __ATOMIC_RELAXED, __HIP_MEMORY_SCOPE_AGENT); }
__device__ __forceinline__ unsigned xb_xcc_id() { return (unsigned)__builtin_amdgcn_s_getreg((3 << 11) | 20) & 0xFu; }
#define XB_SPIN(cond, bar) do { unsigned _sp = 0; while (cond) { __builtin_amdgcn_s_sleep(1); \
    if ((++_sp & 255u) == 0u) { if (xb_ld(&(bar)[XB_TMO])) break; if (_sp > XB_SPIN_CAP) { atomicAdd(&(bar)[XB_TMO], 1u); break; } } } } while (0)

struct XcdBarrier {
    unsigned* bar; unsigned x;
    volatile LAS unsigned* st;
};

__device__ __forceinline__ XcdBarrier xcd_barrier_post(unsigned* bar, volatile LAS unsigned* st) {
    XcdBarrier b; b.bar = bar; b.x = xb_xcc_id(); b.st = st;
    if (threadIdx.x == 0) (void)xb_add(&bar[XB_XCNT(b.x)], 1u);
    return b;
}
__device__ __forceinline__ void xcd_barrier_complete(unsigned* bar, unsigned x, unsigned& nloc, unsigned& nx) {
    const unsigned G = gridDim.x * gridDim.y * gridDim.z;
    unsigned sum, cnt, mine, sp = 0u;
    for (;;) {
        sum = 0u; cnt = 0u; mine = 0u;
#pragma unroll
        for (unsigned j = 0; j < 16; ++j) { const unsigned c = xb_ld(&bar[XB_XCNT(j)]); sum += c; cnt += (c > 0u) ? 1u : 0u; mine = (j == x) ? c : mine; }
        if (sum == G) break;
        __builtin_amdgcn_s_sleep(1);
        if ((++sp & 255u) == 0u) { if (xb_ld(&bar[XB_TMO])) break; if (sp > XB_SPIN_CAP) { atomicAdd(&bar[XB_TMO], 1u); break; } }
    }
    nloc = mine > 0u ? mine : 1u; nx = cnt > 0u ? cnt : 1u;
}

__device__ __forceinline__ void xcd_barrier(const XcdBarrier& b) {
    asm volatile("s_waitcnt vmcnt(0)" ::: "memory");
    __syncthreads();
    if (threadIdx.x == 0) {
        unsigned* bar = b.bar;
        __builtin_amdgcn_s_waitcnt(0);
        unsigned nloc = b.st[0], nx = b.st[1];
        if (nloc == 0u) { xcd_barrier_complete(bar, b.x, nloc, nx); b.st[0] = nloc; b.st[1] = nx; }
        const unsigned old = xb_add(&bar[XB_XSUB(b.x)], 1u);
        const unsigned gen = old / nloc;
        if (old + 1u == (gen + 1u) * nloc) {
            __builtin_amdgcn_fence(__ATOMIC_RELEASE, "agent");
            asm volatile("s_waitcnt vmcnt(0)" ::: "memory");
            const unsigned og = xb_add(&bar[XB_TOP], 1u);
            const unsigned tg = og / nx;
            if (og + 1u == (tg + 1u) * nx) xb_add(&bar[XB_TOPGEN], 1u);
            else XB_SPIN(xb_ld(&bar[XB_TOPGEN]) == tg, bar);
            __builtin_amdgcn_fence(__ATOMIC_ACQUIRE, "agent");
            xb_add(&bar[XB_XGEN(b.x)], 1u);
            asm volatile("s_waitcnt vmcnt(0)" ::: "memory");
        } else {
            XB_SPIN(xb_ld(&bar[XB_XGEN(b.x)]) == gen, bar);
            __builtin_amdgcn_fence(__ATOMIC_ACQUIRE, "agent");
            asm volatile("s_waitcnt vmcnt(0)" ::: "memory");
        }
    }
    __syncthreads();
}
typedef unsigned short bf16_t;
typedef float f32x4 __attribute__((ext_vector_type(4)));
typedef unsigned u32x4 __attribute__((ext_vector_type(4)));
typedef unsigned u32x2 __attribute__((ext_vector_type(2)));
using att::bf16x8; using att::s16x4; using att::f32x16; using att::crow; using att::cvtpk;

constexpr int DM = 2048, SEQ = 8192, CTXL = 256, MROWS = SEQ + CTXL  , NPROJ = 4608, NPROJ_PAD = 4864, INPROJ = 4624, DFF = 5632, NUP = 2 * DFF;
constexpr int OFF_AQ = 0, OFF_AK = 1024, OFF_AV = 1280, OFF_MQ = 1536, OFF_MK = 2048, OFF_MV = 2560, OFF_MO = 3584;
constexpr float EPS = 1e-6f;
constexpr int NSTEP = 132, SROWS = 257; constexpr size_t ST_BLK = (size_t)SROWS * 128;
constexpr size_t MiB = 1u << 20;
constexpr size_t WS_MODX = 0, WS_MODC = 64 * 1024, WS_BL = 128 * 1024, WS_G = 256 * 1024, WS_BAR = 1 * MiB, BAR_BYTES = 65536, WS_CNT1 = 1 * MiB + 16384, WS_CNT2 = 1 * MiB + 32768, WS_SLOT1 = 1 * MiB + 256 * 1024, WS_SLOT2 = 1 * MiB + 512 * 1024;
constexpr size_t WS_WDOWN = 2 * MiB, WS_WIN = 24 * MiB, WS_WOUT = 43 * MiB, WS_WUP = 51 * MiB, WS_H = 95 * MiB, WS_MIX = 128 * MiB, WS_ACT = 24 * MiB;
constexpr size_t WS_P = 160 * MiB, WS_ST = 235 * MiB, WS_U = 160 * MiB, WS_TILE = 256 * MiB, WS_END = 368 * MiB;
constexpr int LDS_BYTES = 131072 + 1024;
constexpr int NPHASE = 12;
#ifndef FLATBAR
#define FLATBAR 0
#endif
#ifndef XTRA_BAR
#define XTRA_BAR 0
#endif
#ifndef REP_ATT
#define REP_ATT 0
#endif
#ifndef PROBE_B
#define PROBE_B 0
#endif
#ifndef PROBE_10
#define PROBE_10 0
#endif
#ifndef FUSE_NORM
#define FUSE_NORM 1
#endif
#ifndef REP_C
#define REP_C 0
#define REP_A 0
#endif
#ifndef REPMASK
#define REPMASK 0
#endif
#ifndef TAILS
#define TAILS 1
#endif

__device__ __forceinline__ float bf2f(unsigned v) { return __uint_as_float(v << 16); }
typedef float f32x2_t __attribute__((ext_vector_type(2))); typedef __bf16 bf16x2_t __attribute__((ext_vector_type(2)));
__device__ __forceinline__ unsigned pkbf(float lo, float hi) { const f32x2_t v = {lo, hi}; const bf16x2_t b = __builtin_convertvector(v, bf16x2_t); return __builtin_bit_cast(unsigned, b); }
__device__ __forceinline__ float wave_sum(float v) {
#pragma unroll
    for (int o = 1; o < 64; o <<= 1) v += __shfl_xor(v, o);
    return v;
}
__device__ __forceinline__ float log_sigmoid(float x) { return fminf(x, 0.f) - log1pf(__expf(-fabsf(x))); }

template <bool UPPERM = false, bool NTST = false> __device__ __forceinline__ void p0_transpose_item(const float* W, int K, int N, bf16_t* WT, LAS float* scr, int item, int lane) {
    const int nblk = (N + 31) / 32, kb = item / nblk, nb = item % nblk, k0 = 64 * kb, n0 = 32 * nb;
    const int nd0 = UPPERM ? (n0 < 5632 ? (n0 >> 7) * 256 + (n0 & 127) : ((n0 - 5632) >> 7) * 256 + 128 + ((n0 - 5632) & 127)) : n0;
    const int c4 = (lane & 7) * 4, kr = lane >> 3; const bool okc = n0 + c4 < N;
    f32x4 v[8];
#pragma unroll
    for (int i = 0; i < 8; ++i) v[i] = okc ? __builtin_nontemporal_load((const f32x4*)(W + (size_t)(k0 + kr + 8 * i) * N + n0 + c4)) : (f32x4){0.f, 0.f, 0.f, 0.f};
#pragma unroll
    for (int i = 0; i < 8; ++i) { LAS float* d = scr + (kr + 8 * i) * 33 + c4; d[0] = v[i].x; d[1] = v[i].y; d[2] = v[i].z; d[3] = v[i].w; }
    asm volatile("s_waitcnt lgkmcnt(0)" ::: "memory");
    const int c = lane & 7;
#pragma unroll
    for (int j = 0; j < 4; ++j) { const int n = (lane >> 3) + 8 * j; const LAS float* s = scr + (8 * c) * 33 + n;
        u32x4 o; o.x = pkbf(s[0 * 33], s[1 * 33]); o.y = pkbf(s[2 * 33], s[3 * 33]); o.z = pkbf(s[4 * 33], s[5 * 33]); o.w = pkbf(s[6 * 33], s[7 * 33]);
        if (NTST) __builtin_nontemporal_store(o, (u32x4*)(WT + (size_t)(nd0 + n) * K + k0 + 8 * c)); else *(u32x4*)(WT + (size_t)(nd0 + n) * K + k0 + 8 * c) = o; }
    asm volatile("s_waitcnt lgkmcnt(0)" ::: "memory");
}
__device__ __forceinline__ void p0_gemv_item(const float* wmod, const float* bmod, float* modx, float* modc, char* lds, int item) {
    const int tid = ltid(); const float* sx = (const float*)lds; const float* sc = sx + 2048; float* red = (float*)(lds + 16384);
    const int n0 = item * 64, c4 = (tid & 15) * 4, kr = tid >> 4;
    f32x4 ax = {0.f, 0.f, 0.f, 0.f}, ac = {0.f, 0.f, 0.f, 0.f};
#pragma unroll 8
    for (int j = 0; j < 64; ++j) { const int k = kr + 32 * j; const f32x4 w = __builtin_nontemporal_load((const f32x4*)(wmod + (size_t)k * 12288 + n0 + c4)); ax += w * sx[k]; ac += w * sc[k]; }
    *(f32x4*)(red + (kr * 16 + (tid & 15)) * 8) = ax; *(f32x4*)(red + (kr * 16 + (tid & 15)) * 8 + 4) = ac;
    __syncthreads();
    if (tid < 128) { const int col = tid & 63, which = tid >> 6; float s = 0.f;
        for (int k2 = 0; k2 < 32; ++k2) s += red[(k2 * 16 + (col >> 2)) * 8 + which * 4 + (col & 3)];
        s += bmod[n0 + col]; (which ? modc : modx)[n0 + col] = s; }
    __syncthreads();
}
__device__ __forceinline__ void norm_mod_row(const float* xrow, const float* g, const float* sh, const float* sc, bf16_t* orow, int lane) {
    const f32x4* xr = (const f32x4*)xrow + lane; f32x4 v[8]; float s = 0.f;
#pragma unroll
    for (int j = 0; j < 8; ++j) { v[j] = __builtin_nontemporal_load(xr + 64 * j); s += (v[j].x * v[j].x + v[j].y * v[j].y) + (v[j].z * v[j].z + v[j].w * v[j].w); }
    const float rstd = rsqrtf(wave_sum(s) * (1.f / 2048.f) + EPS);
    u32x2* o8 = (u32x2*)orow + lane;
#pragma unroll
    for (int j = 0; j < 8; ++j) { const f32x4 gg = ((const f32x4*)g)[lane + 64 * j], s1 = ((const f32x4*)sc)[lane + 64 * j], s0 = ((const f32x4*)sh)[lane + 64 * j];
        const f32x4 y = (v[j] * rstd * gg) * (s1 + 1.0f) + s0; u32x2 w; w.x = pkbf(y.x, y.y); w.y = pkbf(y.z, y.w); o8[64 * j] = w; }
}
__device__ __forceinline__ void final_norm_row(float* xrow, const float* g, int lane) {
    f32x4* xr = (f32x4*)xrow + lane; f32x4 v[8]; float s = 0.f;
#pragma unroll
    for (int j = 0; j < 8; ++j) { v[j] = xr[64 * j]; s += (v[j].x * v[j].x + v[j].y * v[j].y) + (v[j].z * v[j].z + v[j].w * v[j].w); }
    const float rstd = rsqrtf(wave_sum(s) * (1.f / 2048.f) + EPS);
#pragma unroll
    for (int j = 0; j < 8; ++j) { const f32x4 gg = ((const f32x4*)g)[lane + 64 * j]; xr[64 * j] = v[j] * rstd * gg; }
}
constexpr int QK_TASKS = SEQ * 10 + CTXL * 2;
__device__ __forceinline__ void qk_prep_task(bf16_t* P, int t, const float* qn, const float* kn, int lane) {
    int row, hh; if (t < SEQ * 10) { row = t / 10; hh = t - row * 10; } else { const int t2 = t - SEQ * 10; row = SEQ + (t2 >> 1); hh = 8 + (t2 & 1); }
    const bool is_x = row < SEQ; const int sl = lane & 7, half = sl >> 2, i0 = (sl & 3) * 8, e1 = 64 * half + i0;
    bf16_t* hp = P + (size_t)row * NPROJ + (hh < 8 ? OFF_AQ + hh * 128 : OFF_AK + (hh - 8) * 128) + e1;
    const u32x4 ra = *(const u32x4*)hp, rb = *(const u32x4*)(hp + 32);
    const float* gn = (hh < 8 ? qn : kn) + e1;
    const f32x4 ga0 = *(const f32x4*)gn, ga1 = *(const f32x4*)(gn + 4), gb0 = *(const f32x4*)(gn + 32), gb1 = *(const f32x4*)(gn + 36);
    float x1[8], x2[8]; float ss = 0.f;
#pragma unroll
    for (int j = 0; j < 4; ++j) { x1[2 * j] = __uint_as_float(ra[j] << 16); x1[2 * j + 1] = __uint_as_float(ra[j] & 0xffff0000u); x2[2 * j] = __uint_as_float(rb[j] << 16); x2[2 * j + 1] = __uint_as_float(rb[j] & 0xffff0000u); }
#pragma unroll
    for (int j = 0; j < 8; ++j) ss += x1[j] * x1[j] + x2[j] * x2[j];
    ss += __shfl_xor(ss, 1); ss += __shfl_xor(ss, 2); ss += __shfl_xor(ss, 4);
    const float rstd = rsqrtf(ss * (1.f / 128.f) + EPS);
    const float pos = (float)(half == 0 ? (row >> 6) : (row & 63));
    float o1[8], o2[8];
#pragma unroll
    for (int j = 0; j < 8; ++j) {
        float cs = 1.f, sn = 0.f;
        if (is_x) { const float invf = exp2f(-(float)(i0 + j) * (13.287712379549449f / 32.0f));
            const float rev = pos * invf * 0.15915494309189535f; cs = __builtin_amdgcn_cosf(rev); sn = __builtin_amdgcn_sinf(rev); }
        const float y1 = x1[j] * rstd * (j < 4 ? ga0[j & 3] : ga1[j & 3]), y2 = x2[j] * rstd * (j < 4 ? gb0[j & 3] : gb1[j & 3]);
        o1[j] = y1 * cs - y2 * sn; o2[j] = y2 * cs + y1 * sn; }
    u32x4 wa, wb;
#pragma unroll
    for (int j = 0; j < 4; ++j) { wa[j] = pkbf(o1[2 * j], o1[2 * j + 1]); wb[j] = pkbf(o2[2 * j], o2[2 * j + 1]); }
    *(u32x4*)hp = wa; *(u32x4*)(hp + 32) = wb;
}
__device__ __forceinline__ void gate_scan(const float* G, const float* b_i, const float* b_f, int row0, int h, int dir, int lane, float& b, float& ip, float& bL) {
    const float* g = G + (size_t)(row0 + lane) * 16 + dir * 8;
    ip = g[h] + b_i[dir * 4 + h];
    b = log_sigmoid(g[4 + h] + b_f[dir * 4 + h]);
    if (dir == 0) {
#pragma unroll
        for (int o = 1; o < 64; o <<= 1) { const float v = __shfl_up(b, o); if (lane >= o) b += v; }
        bL = __shfl(b, 63);
    } else {
#pragma unroll
        for (int o = 1; o < 64; o <<= 1) { const float v = __shfl_down(b, o); if (lane + o < 64) b += v; }
        bL = __shfl(b, 0);
    }
}
__device__ __forceinline__ s16x4 vtr(const LAS char* p) { typedef short v4i16_t __attribute__((ext_vector_type(4)));
    return __builtin_bit_cast(s16x4, __builtin_amdgcn_ds_read_tr16_b64_v4i16((LAS v4i16_t*)p)); }
__device__ __forceinline__ bf16x8 trfrag(const LAS char* base, int off) { const s16x4 l = vtr(base + off), h = vtr(base + off + 2048);
    return (bf16x8){l[0], l[1], l[2], l[3], h[0], h[1], h[2], h[3]}; }
__device__ __forceinline__ bf16x8 scale8(bf16x8 k, float w) { const u32x4 u = __builtin_bit_cast(u32x4, k); u32x4 o;
#pragma unroll
    for (int j = 0; j < 4; ++j) o[j] = pkbf(__uint_as_float(u[j] << 16) * w, __uint_as_float(u[j] & 0xffff0000u) * w);
    return __builtin_bit_cast(bf16x8, o); }
__device__ __forceinline__ bf16x8 pack8(f32x4 a, f32x4 b) { u32x4 o; o.x = pkbf(a.x, a.y); o.y = pkbf(a.z, a.w); o.z = pkbf(b.x, b.y); o.w = pkbf(b.z, b.w); return __builtin_bit_cast(bf16x8, o); }
__device__ __forceinline__ int step_of(int dir, int c) { return dir == 0 ? (c < 128 ? c + 4 : c - 128) : 131 - c; }

__device__ __forceinline__ void mlstm_passA(char* lds, const bf16_t* P, const float* G, const float* b_i, const float* b_f, bf16_t* ST, float* BL, int item) {
    const int tid = ltid(), wid = tid >> 6, lane = tid & 63, r32 = lane & 31, hi = lane >> 5;
    const int c = item >> 2, h = item & 3, row0 = c * 64;
    float* wts = (float*)(lds + 65536);
    if (wid < 2) { float b, ip, bL; gate_scan(G, b_i, b_f, row0, h, wid, lane, b, ip, bL); wts[wid * 64 + lane] = __expf(bL - b + ip);
        if (lane == 0) BL[(wid * 4 + h) * NSTEP + step_of(wid, c)] = bL; }
    __syncthreads();
#pragma unroll
    for (int i = 0; i < 4; ++i) { const int p = tid + 512 * i, r = p >> 5, cc = (p & 31) * 8;
        const bf16x8 v = *(const bf16x8*)(P + (size_t)(row0 + r) * NPROJ + OFF_MV + h * 256 + cc);
        *(bf16x8*)(lds + (cc >> 7) * 16384 + att::v_st(r, cc & 127)) = v; }
#pragma unroll
    for (int i = 0; i < 2; ++i) { const int p = tid + 512 * i, r = p >> 4, cc = (p & 15) * 8;
        const bf16x8 k = *(const bf16x8*)(P + (size_t)(row0 + r) * NPROJ + OFF_MK + h * 128 + cc);
        *(bf16x8*)(lds + 32768 + att::v_st(r, cc)) = scale8(k, wts[r]); *(bf16x8*)(lds + 49152 + att::v_st(r, cc)) = scale8(k, wts[64 + r]); }
    __syncthreads();
    const int dir = wid >> 2, cb = wid & 3;
    const LAS char* L = (const LAS char*)lds + att::v_rd_base(lane);
    const LAS char* La = L + (cb >> 1) * 16384 + ((2 * cb) & 3) * 512;
    const LAS char* Lb = L + 32768 + dir * 16384;
    bf16_t* base = ST + ((size_t)(dir * 4 + h) * NSTEP + step_of(dir, c)) * ST_BLK;
#pragma nounroll
    for (int a = 0; a < 2; ++a) {
        f32x16 acc[4];
#pragma unroll
        for (int b = 0; b < 4; ++b) acc[b] = f32x16{};
        const LAS char* Laa = La + a * 512;
#pragma unroll
        for (int ks = 0; ks < 4; ++ks) {
            const bf16x8 A = trfrag(Laa, ks * 4096);
#pragma unroll
            for (int b = 0; b < 4; ++b) acc[b] = __builtin_amdgcn_mfma_f32_32x32x16_bf16(A, trfrag(Lb, b * 512 + ks * 4096), acc[b], 0, 0, 0);
        }
#pragma unroll
        for (int b = 0; b < 4; ++b)
#pragma unroll
            for (int r = 0; r < 16; ++r) base[(size_t)(64 * cb + 32 * a + crow(r, hi)) * 128 + 32 * b + r32] = (bf16_t)(pkbf(acc[b][r], acc[b][r]) & 0xffffu);
    }
    if (cb == 0) {
        f32x16 an[4];
#pragma unroll
        for (int b = 0; b < 4; ++b) an[b] = f32x16{};
        const short one = (r32 == 0) ? (short)0x3F80 : (short)0; const bf16x8 A1 = {one, one, one, one, one, one, one, one};
#pragma unroll
        for (int ks = 0; ks < 4; ++ks)
#pragma unroll
            for (int b = 0; b < 4; ++b) an[b] = __builtin_amdgcn_mfma_f32_32x32x16_bf16(A1, trfrag(Lb, b * 512 + ks * 4096), an[b], 0, 0, 0);
        if (hi == 0) {
#pragma unroll
            for (int b = 0; b < 4; ++b) base[(size_t)256 * 128 + 32 * b + r32] = (bf16_t)(pkbf(an[b][0], an[b][0]) & 0xffffu);
        }
    }
    __syncthreads();
}
__device__ __forceinline__ void mlstm_passB(bf16_t* ST, const float* BL, bf16_t* DST = nullptr, int ndh = 8) {
    constexpr int PER = (int)(ST_BLK / 2); constexpr size_t SB = ST_BLK / 2;
    const int nthr = gridDim.x * 512;
    for (int e = blockIdx.x * 512 + ltid(); e < ndh * PER; e += nthr) {
        const int dh = e / PER, idx = e - dh * PER;
        unsigned* p = (unsigned*)(ST + (size_t)dh * NSTEP * ST_BLK) + idx; const float* bl = BL + dh * NSTEP;
        unsigned* q = DST ? (unsigned*)(DST + (size_t)dh * NSTEP * ST_BLK) + idx : p;
        float c0 = 0.f, c1 = 0.f;
        unsigned cur[12], nxt[12];
#pragma unroll
        for (int j = 0; j < 12; ++j) cur[j] = p[(size_t)j * SB];
        for (int s = 0; s < NSTEP; s += 12) {
#pragma unroll
            for (int j = 0; j < 12; ++j) nxt[j] = (s + 12 + j < NSTEP) ? p[(size_t)(s + 12 + j) * SB] : 0u;
#pragma unroll
            for (int j = 0; j < 12; ++j) { const float d = __expf(bl[s + j]);
                q[(size_t)(s + j) * SB] = pkbf(c0, c1);
                c0 = c0 * d + __uint_as_float(cur[j] << 16); c1 = c1 * d + __uint_as_float(cur[j] & 0xffff0000u); }
#pragma unroll
            for (int j = 0; j < 12; ++j) cur[j] = nxt[j];
        }
    }
}
__device__ __forceinline__ void mlstm_passC(char* lds, const bf16_t* P, const float* G, const float* b_i, const float* b_f, const bf16_t* ST, const float* mnorm, bf16_t* MIX, int item) {
    const int tid = ltid(), wid = tid >> 6, lane = tid & 63, r32 = lane & 31, hi = lane >> 5;
    const int c = item >> 2, h = item & 3, row0 = c * 64;
    float* bq = (float*)(lds + 49152); float* ak = bq + 128; float* eq = ak + 128; float* ssq = eq + 128;
    if (wid < 2) { float b, ip, bL; gate_scan(G, b_i, b_f, row0, h, wid, lane, b, ip, bL); bq[wid * 64 + lane] = b; ak[wid * 64 + lane] = b - ip; eq[wid * 64 + lane] = __expf(b); }
    { const int sr = tid >> 4, sc = (tid & 15) * 8;
#pragma unroll
      for (int i = 0; i < 2; ++i) { const int r = sr + 32 * i; const bf16x8 k = *(const bf16x8*)(P + (size_t)(row0 + r) * NPROJ + OFF_MK + h * 128 + sc);
          *(bf16x8*)(lds + KSWZ(r, sc * 2)) = k; } }
#pragma unroll
    for (int i = 0; i < 4; ++i) { const int p = tid + 512 * i, r = p >> 5, cc = (p & 31) * 8;
        const bf16x8 v = *(const bf16x8*)(P + (size_t)(row0 + r) * NPROJ + OFF_MV + h * 256 + cc);
        *(bf16x8*)(lds + 16384 + (cc >> 7) * 16384 + att::v_st(r, cc & 127)) = v; }
    const int rb = wid >> 2, cb = wid & 3, q = 32 * rb + r32;
    bf16x8 qr[8];
    { const bf16_t* Qw = P + (size_t)(row0 + q) * NPROJ + OFF_MQ + h * 128 + hi * 8;
#pragma unroll
      for (int d0 = 0; d0 < 8; ++d0) qr[d0] = *(const bf16x8*)(Qw + d0 * 16); }
    bf16x8 fr[3][8];
#define LOAD_FR(d) do { const bf16_t* base_ = ST + ((size_t)((d) * 4 + h) * NSTEP + step_of((d), c)) * ST_BLK; \
        _Pragma("unroll") for (int t = 0; t < 3; ++t) { const bf16_t* src = base_ + (size_t)(t < 2 ? 64 * cb + 32 * t + r32 : 256) * 128 + 8 * hi; \
            _Pragma("unroll") for (int ks = 0; ks < 8; ++ks) { fr[t][ks] = (bf16x8){0, 0, 0, 0, 0, 0, 0, 0}; if (t < 2 || r32 == 0) fr[t][ks] = *(const bf16x8*)(src + 16 * ks); } } } while (0)
    LOAD_FR(0);
    __syncthreads();
    f32x16 acc[2][3];
#pragma unroll
    for (int d = 0; d < 2; ++d)
#pragma unroll
        for (int t = 0; t < 3; ++t) acc[d][t] = f32x16{};
#pragma unroll
    for (int d = 0; d < 2; ++d) {
        if (d == 1) LOAD_FR(1);
#pragma unroll
        for (int t = 0; t < 3; ++t)
#pragma unroll
            for (int ks = 0; ks < 8; ++ks) acc[d][t] = __builtin_amdgcn_mfma_f32_32x32x16_bf16(qr[ks], fr[t][ks], acc[d][t], 0, 0, 0);
#pragma unroll
        for (int r = 0; r < 16; ++r) { const float e = eq[d * 64 + 32 * rb + crow(r, hi)];
#pragma unroll
            for (int t = 0; t < 3; ++t) acc[d][t][r] *= e; }
    }
#undef LOAD_FR
    float ogv[2][16], mnv[2];
#pragma unroll
    for (int t = 0; t < 2; ++t) { const int col = 64 * cb + 32 * t + r32; mnv[t] = mnorm[h * 256 + col];
#pragma unroll
        for (int r = 0; r < 16; ++r) ogv[t][r] = bf2f(P[(size_t)(row0 + 32 * rb + crow(r, hi)) * NPROJ + OFF_MO + h * 256 + col]); }
    f32x16 p0, p1; att::qkt(p0, p1, (const bf16_t*)lds, qr, r32, hi);
    const LAS char* Lv = (const LAS char*)lds + 16384 + att::v_rd_base(lane) + (cb >> 1) * 16384 + ((2 * cb) & 3) * 512;
    const short one = (r32 == 0) ? (short)0x3F80 : (short)0; const bf16x8 B1 = {one, one, one, one, one, one, one, one};
#pragma unroll
    for (int d = 0; d < 2; ++d) {
        const float bqv = bq[d * 64 + q]; f32x16 e0, e1;
#pragma unroll
        for (int r = 0; r < 16; ++r) { const int k0 = crow(r, hi), k1 = 32 + k0;
            const bool v0 = d == 0 ? (k0 <= q) : (k0 >= q), v1 = d == 0 ? (k1 <= q) : (k1 >= q);
            const float x0 = __expf(bqv - ak[d * 64 + k0]), x1 = __expf(bqv - ak[d * 64 + k1]);
            e0[r] = v0 ? p0[r] * x0 : 0.f; e1[r] = v1 ? p1[r] * x1 : 0.f; }
        bf16x8 pa0, pa1, pa2, pa3; PK4(e0, 0, pa0); PK4(e0, 8, pa1); PK4(e1, 0, pa2); PK4(e1, 8, pa3);
#pragma unroll
        for (int t = 0; t < 2; ++t) {
            acc[d][t] = __builtin_amdgcn_mfma_f32_32x32x16_bf16(pa0, trfrag(Lv, t * 512 + 0 * 4096), acc[d][t], 0, 0, 0);
            acc[d][t] = __builtin_amdgcn_mfma_f32_32x32x16_bf16(pa1, trfrag(Lv, t * 512 + 1 * 4096), acc[d][t], 0, 0, 0);
            acc[d][t] = __builtin_amdgcn_mfma_f32_32x32x16_bf16(pa2, trfrag(Lv, t * 512 + 2 * 4096), acc[d][t], 0, 0, 0);
            acc[d][t] = __builtin_amdgcn_mfma_f32_32x32x16_bf16(pa3, trfrag(Lv, t * 512 + 3 * 4096), acc[d][t], 0, 0, 0);
        }
        acc[d][2] = __builtin_amdgcn_mfma_f32_32x32x16_bf16(pa0, B1, acc[d][2], 0, 0, 0);
        acc[d][2] = __builtin_amdgcn_mfma_f32_32x32x16_bf16(pa1, B1, acc[d][2], 0, 0, 0);
        acc[d][2] = __builtin_amdgcn_mfma_f32_32x32x16_bf16(pa2, B1, acc[d][2], 0, 0, 0);
        acc[d][2] = __builtin_amdgcn_mfma_f32_32x32x16_bf16(pa3, B1, acc[d][2], 0, 0, 0);
    }
    f32x16 hv[2];
#pragma unroll
    for (int r = 0; r < 16; ++r) {
        const int f0 = __builtin_amdgcn_readlane(__float_as_int(acc[0][2][r]), 0), f1 = __builtin_amdgcn_readlane(__float_as_int(acc[0][2][r]), 32);
        const int g0 = __builtin_amdgcn_readlane(__float_as_int(acc[1][2][r]), 0), g1 = __builtin_amdgcn_readlane(__float_as_int(acc[1][2][r]), 32);
        const float df = __int_as_float(hi ? f1 : f0), db = __int_as_float(hi ? g1 : g0);
        const float invf = __builtin_amdgcn_rcpf(fmaxf(fabsf(df), 1.0f)), invb = __builtin_amdgcn_rcpf(fmaxf(fabsf(db), 1.0f));
        hv[0][r] = acc[0][0][r] * invf + acc[1][0][r] * invb; hv[1][r] = acc[0][1][r] * invf + acc[1][1][r] * invb;
    }
    { float s16[16];
#pragma unroll
      for (int r = 0; r < 16; ++r) s16[r] = hv[0][r] * hv[0][r] + hv[1][r] * hv[1][r];
      float s8[8], s4[4], s2[2], s1;
#pragma unroll
      for (int r = 0; r < 8; ++r) { const float keep = (lane & 16) ? s16[8 + r] : s16[r], give = (lane & 16) ? s16[r] : s16[8 + r]; s8[r] = keep + __shfl_xor(give, 16); }
#pragma unroll
      for (int r = 0; r < 4; ++r) { const float keep = (lane & 8) ? s8[4 + r] : s8[r], give = (lane & 8) ? s8[r] : s8[4 + r]; s4[r] = keep + __shfl_xor(give, 8); }
#pragma unroll
      for (int r = 0; r < 2; ++r) { const float keep = (lane & 4) ? s4[2 + r] : s4[r], give = (lane & 4) ? s4[r] : s4[2 + r]; s2[r] = keep + __shfl_xor(give, 4); }
      { const float keep = (lane & 2) ? s2[1] : s2[0], give = (lane & 2) ? s2[0] : s2[1]; s1 = keep + __shfl_xor(give, 2); }
      s1 += __shfl_xor(s1, 1);
      const int rr = ((lane >> 4) & 1) * 8 + ((lane >> 3) & 1) * 4 + ((lane >> 2) & 1) * 2 + ((lane >> 1) & 1);
      if ((lane & 1) == 0) ssq[cb * 64 + 32 * rb + crow(rr, hi)] = s1; }
    __syncthreads();
#pragma unroll
    for (int r = 0; r < 16; ++r) { const int row = 32 * rb + crow(r, hi); const float rstd = rsqrtf(((ssq[row] + ssq[64 + row]) + (ssq[128 + row] + ssq[192 + row])) * (1.f / 256.f) + EPS);
#pragma unroll
        for (int t = 0; t < 2; ++t) { const int col = 64 * cb + 32 * t + r32;
            const float val = hv[t][r] * rstd * mnv[t] * ogv[t][r];
            MIX[(size_t)(row0 + row) * DM + 1024 + h * 256 + col] = (bf16_t)(pkbf(val, val) & 0xffffu); } }
    __syncthreads();
}
__device__ __forceinline__ void conv_gate_item(const bf16_t* U, const float* cw, const float* cbias, bf16_t* ACT, int item) {
    const int cgp = item % 704, rr = item / 704, j0 = cgp * 8, t0 = rr * 16;
    float w0g[8], w1g[8], w2g[8], bg[8], w0v[8], w1v[8], w2v[8], bv[8];
#pragma unroll
    for (int j = 0; j < 8; ++j) { w0g[j] = cw[j0 + j]; w1g[j] = cw[NUP + j0 + j]; w2g[j] = cw[2 * NUP + j0 + j]; bg[j] = cbias[j0 + j];
        w0v[j] = cw[DFF + j0 + j]; w1v[j] = cw[NUP + DFF + j0 + j]; w2v[j] = cw[2 * NUP + DFF + j0 + j]; bv[j] = cbias[DFF + j0 + j]; }
    const u32x4 z = {0u, 0u, 0u, 0u};
    u32x4 pg = z, pv = z;
    if (t0 > 0) { pg = __builtin_nontemporal_load((const u32x4*)(U + (size_t)(t0 - 1) * NUP + j0)); pv = __builtin_nontemporal_load((const u32x4*)(U + (size_t)(t0 - 1) * NUP + DFF + j0)); }
    u32x4 cg_ = __builtin_nontemporal_load((const u32x4*)(U + (size_t)t0 * NUP + j0)), cv = __builtin_nontemporal_load((const u32x4*)(U + (size_t)t0 * NUP + DFF + j0));
    for (int t = t0; t < t0 + 16; ++t) {
        u32x4 ng = z, nv = z;
        if (t + 1 < SEQ) { ng = __builtin_nontemporal_load((const u32x4*)(U + (size_t)(t + 1) * NUP + j0)); nv = __builtin_nontemporal_load((const u32x4*)(U + (size_t)(t + 1) * NUP + DFF + j0)); }
        u32x4 o;
#pragma unroll
        for (int jj = 0; jj < 4; ++jj) {
            float r2[2];
#pragma unroll
            for (int e = 0; e < 2; ++e) { const int j = 2 * jj + e;
                const float a = e ? __uint_as_float(pg[jj] & 0xffff0000u) : __uint_as_float(pg[jj] << 16);
                const float b = e ? __uint_as_float(cg_[jj] & 0xffff0000u) : __uint_as_float(cg_[jj] << 16);
                const float d = e ? __uint_as_float(ng[jj] & 0xffff0000u) : __uint_as_float(ng[jj] << 16);
                const float av = e ? __uint_as_float(pv[jj] & 0xffff0000u) : __uint_as_float(pv[jj] << 16);
                const float bvv = e ? __uint_as_float(cv[jj] & 0xffff0000u) : __uint_as_float(cv[jj] << 16);
                const float dv = e ? __uint_as_float(nv[jj] & 0xffff0000u) : __uint_as_float(nv[jj] << 16);
                const float gc = w0g[j] * a + w1g[j] * b + w2g[j] * d + bg[j];
                const float vc = w0v[j] * av + w1v[j] * bvv + w2v[j] * dv + bv[j];
                r2[e] = gc * __builtin_amdgcn_rcpf(1.0f + __builtin_amdgcn_exp2f(-1.4426950408889634f * gc)) * vc; }
            o[jj] = pkbf(r2[0], r2[1]); }
        *(u32x4*)(ACT + (size_t)t * DFF + j0) = o;
        pg = cg_; pv = cv; cg_ = ng; cv = nv;
    }
}

__device__ __forceinline__ void flat_barrier(unsigned* cnt, unsigned target) {
    asm volatile("s_waitcnt vmcnt(0)" ::: "memory");
    __syncthreads();
    if (threadIdx.x == 0) {
        __builtin_amdgcn_fence(__ATOMIC_RELEASE, "agent");
        asm volatile("s_waitcnt vmcnt(0)" ::: "memory");
        __hip_atomic_fetch_add(cnt, 1u, __ATOMIC_RELAXED, __HIP_MEMORY_SCOPE_AGENT);
        unsigned sp = 0;
        while (__hip_atomic_load(cnt, __ATOMIC_RELAXED, __HIP_MEMORY_SCOPE_AGENT) < target) { __builtin_amdgcn_s_sleep(1); if (++sp > (1u << 22)) break; }
        __builtin_amdgcn_fence(__ATOMIC_ACQUIRE, "agent");
        asm volatile("s_waitcnt vmcnt(0)" ::: "memory");
    }
    __syncthreads();
}
struct Args { const float* in[20]; float* out; unsigned char* ws; int ph_lo, ph_hi, coop, pad; };

__global__ void __launch_bounds__(512) fwd_kernel(Args a) {
    extern __shared__ __attribute__((aligned(16))) unsigned char lds[];
    const int G_ = gridDim.x, bid = blockIdx.x; const int NGW = G_ * 8;
#define TIDS const int tid = ltid(), lane = tid & 63, wave = __builtin_amdgcn_readfirstlane(tid >> 6), gw = bid * 8 + wave; (void)tid; (void)lane; (void)gw
#define x_in (a.in[0])
#define cvec (a.in[1])
#define ctx (a.in[2])
#define cctx (a.in[3])
#define wmod (a.in[4])
#define bmod (a.in[5])
#define norm1 (a.in[6])
#define w_in (a.in[7])
#define qn (a.in[8])
#define kn (a.in[9])
#define b_ig (a.in[10])
#define b_fg (a.in[11])
#define mnorm (a.in[12])
#define w_out (a.in[13])
#define norm2 (a.in[14])
#define w_up (a.in[15])
#define convw (a.in[16])
#define convb (a.in[17])
#define w_down (a.in[18])
#define normf (a.in[19])
#define outp (a.out)
#define modx ((float*)(a.ws + WS_MODX))
#define modc ((float*)(a.ws + WS_MODC))
#define BL ((float*)(a.ws + WS_BL))
#define Gt ((float*)(a.ws + WS_G))
#define Wdown_t ((bf16_t*)(a.ws + WS_WDOWN))
#define Win_t ((bf16_t*)(a.ws + WS_WIN))
#define Wout_t ((bf16_t*)(a.ws + WS_WOUT))
#define Wup_t ((bf16_t*)(a.ws + WS_WUP))
#define H ((bf16_t*)(a.ws + WS_H))
#define MIX ((bf16_t*)(a.ws + WS_MIX))
#define ACT ((bf16_t*)(a.ws + WS_ACT))
#define P ((bf16_t*)(a.ws + WS_P))
#define ST ((bf16_t*)(a.ws + WS_ST))
#define U ((bf16_t*)(a.ws + WS_U))
    const int lo = a.ph_lo, hi_ = a.ph_hi;
#ifndef PH_MASK
#define PH_MASK 0xfff
#endif
#define IN(k) (((PH_MASK >> (k)) & 1) && lo <= (k) && (k) < hi_)
#if FLATBAR
    unsigned bar_epoch = 0;
#define SEAM(k) do { if (IN(k) && IN((k) + 1)) { bar_epoch += gridDim.x; flat_barrier((unsigned*)(a.ws + WS_BAR) + 64, bar_epoch); } } while (0)
#else
#define SEAM(k) do { if (IN(k) && IN((k) + 1)) xcd_barrier(bar); } while (0)
#endif
    if (threadIdx.x < 32) ((volatile LAS unsigned*)((LAS unsigned char*)lds + 131072))[threadIdx.x] = 0u;
    __syncthreads();
    XcdBarrier bar; bar.bar = (unsigned*)(a.ws + WS_BAR); bar.x = 0; bar.st = nullptr;
    if (a.coop) { bar = xcd_barrier_post((unsigned*)(a.ws + WS_BAR), (volatile LAS unsigned*)((LAS unsigned char*)lds + 131072)); cg::this_grid().sync(); }

    for (int rep_ = 0; rep_ < (IN(0) ? 1 + ((REPMASK >> 0) & 1) : 0); ++rep_) { TIDS;
        float* sx = (float*)lds;
        for (int i = tid; i < 2048; i += 512) { const float v = cvec[i]; sx[i] = v / (1.0f + __expf(-v)); const float w = cctx[i]; sx[2048 + i] = w / (1.0f + __expf(-w)); }
        __syncthreads();
        for (int it = bid; it < 192; it += G_) p0_gemv_item(wmod, bmod, modx, modc, (char*)lds, it);
        LAS float* scr = (LAS float*)((LAS unsigned char*)lds + 32768 + wave * 8448);
        constexpr int I_IN = 32 * 145;
        for (int it = gw; it < I_IN; it += NGW) p0_transpose_item(w_in, DM, INPROJ, Win_t, scr, it, lane);
#if !TAILS
        { constexpr int I_OUT = 32 * 64, I_UP = 32 * 352, I_DOWN = 88 * 64;
          for (int it = gw; it < I_OUT + I_UP + I_DOWN; it += NGW) { if (it < I_OUT) p0_transpose_item(w_out, DM, DM, Wout_t, scr, it, lane); else if (it < I_OUT + I_UP) p0_transpose_item(w_up, DM, NUP, Wup_t, scr, it - I_OUT, lane);
              else p0_transpose_item(w_down, DFF, DM, Wdown_t, scr, it - I_OUT - I_UP, lane); } }
#endif
    }
    SEAM(0);
#if XTRA_BAR
    for (int xb_ = 0; xb_ < XTRA_BAR; ++xb_) SEAM(0);
#endif
    for (int rep_ = 0; rep_ < (IN(1) ? 1 + ((REPMASK >> 1) & 1) : 0); ++rep_) { TIDS;
        for (int m = gw; m < MROWS; m += NGW) { const bool isx = m < SEQ; const float* md = isx ? modx : modc;
            norm_mod_row(isx ? x_in + (size_t)m * DM : ctx + (size_t)(m - SEQ) * DM, norm1, md, md + 2048, H + (size_t)m * DM, lane); }
    }
    SEAM(1);
    for (int rep_ = 0; rep_ < (IN(2) ? 1 + ((REPMASK >> 2) & 1) : 0); ++rep_) {
        pg8::Gemm g{H, Win_t, MROWS, NPROJ_PAD, DM}; pg8::StaticOrder S; S.init(MROWS, NPROJ_PAD, G_, bid);
        pg8::EpiInProj E{P, Gt};
        pg8::gemm_phase<pg8::EpiInProj, pg8::StaticOrder, true, true>((LAS unsigned char*)lds, g, S, E);
#if TAILS
        { TIDS; constexpr int NWG = (MROWS / 256) * (NPROJ_PAD / 256); const int R = (NWG + G_ - 1) / G_, thr = NWG - (R - 1) * G_, NL = R * G_ - NWG;
          LAS float* scr = (LAS float*)((LAS unsigned char*)lds + 32768 + wave * 8448);
          constexpr int I_OUT = 32 * 64, I_UP = 32 * 352;
          const int lw = NL > 0 ? (bid - thr) * 8 + wave : gw, nlw = NL > 0 ? NL * 8 : NGW;
          if (NL == 0 || bid >= thr)
              for (int it = lw; it < I_OUT + I_UP; it += nlw) { if (it < I_OUT) p0_transpose_item<false, true>(w_out, DM, DM, Wout_t, scr, it, lane); else p0_transpose_item<false, true>(w_up, DM, NUP, Wup_t, scr, it - I_OUT, lane); } }
#endif
        __syncthreads();
    }
    SEAM(2);
    for (int rep_ = 0; rep_ < (IN(3) ? 1 + ((REPMASK >> 3) & 1) : 0); ++rep_) { TIDS;
        for (int ra_ = 0; ra_ < 1 + REP_A; ++ra_)
        for (int it = bid; it < NSTEP * 4; it += G_) mlstm_passA((char*)lds, P, Gt, b_ig, b_fg, ST, BL, it);
        for (int wi = gw; wi < QK_TASKS / 8; wi += NGW) qk_prep_task(P, wi * 8 + (lane >> 3), qn, kn, lane);
    }
    SEAM(3);
#if PROBE_B
    if (IN(4)) mlstm_passB(ST, BL, (bf16_t*)outp, 7);
#endif
    if (IN(4)) mlstm_passB(ST, BL);
    SEAM(4);
    for (int rep_ = 0; rep_ < (IN(5) ? 1 + ((REPMASK >> 5) & 1) : 0); ++rep_) {
#ifndef P5_SKIP_ATT
        for (int rt_ = 0; rt_ < 1 + REP_ATT; ++rt_)
        for (int u = bid; u < 256; u += G_) { const int hq = u & 7, qb = u >> 3, kvh = hq >> 2;
            att::attn_dense_body(P + (size_t)(qb * 256) * NPROJ + OFF_AQ + hq * 128, P + OFF_AK + kvh * 128, P + OFF_AV + kvh * 128,
                                 MIX + (size_t)(qb * 256) * DM + hq * 128, MROWS, (char*)lds);
            __syncthreads(); }
#endif
#ifndef P5_SKIP_C
        for (int rc_ = 0; rc_ < 1 + REP_C; ++rc_)
        for (int it = bid; it < 128 * 4; it += G_) mlstm_passC((char*)lds, P, Gt, b_ig, b_fg, ST, mnorm, MIX, it);
#endif
    }
    SEAM(5);
    for (int rep_ = 0; rep_ < (IN(6) ? 1 : 0); ++rep_) {
        pg8::Gemm g{MIX, Wout_t, SEQ, DM, DM}; pg8::StaticOrder S; S.init(SEQ, DM, G_, bid);
        if (G_ == 256 && FUSE_NORM) {
            pg8::EpiResidNormMod E{x_in, outp, modx + 4096, norm2, modx + 6144, modx + 8192, H, pg8::RowStats{(float*)(a.ws + WS_SLOT1), (unsigned*)(a.ws + WS_CNT1)}};
            pg8::gemm_phase<pg8::EpiResidNormMod, pg8::StaticOrder, false, true>((LAS unsigned char*)lds, g, S, E);
        } else {
            pg8::EpiResid E{x_in, outp, modx + 4096};
            pg8::gemm_phase<pg8::EpiResid, pg8::StaticOrder, true, true>((LAS unsigned char*)lds, g, S, E);
        }
    }
    if (!(G_ == 256 && FUSE_NORM)) {
    SEAM(6);
    for (int rep_ = 0; rep_ < (IN(7) ? 1 : 0); ++rep_) { TIDS;
        for (int m = gw; m < SEQ; m += NGW) norm_mod_row(outp + (size_t)m * DM, norm2, modx + 6144, modx + 8192, H + (size_t)m * DM, lane);
    }
    }
    SEAM(7);
    for (int rep_ = 0; rep_ < (IN(8) ? 1 + ((REPMASK >> 8) & 1) : 0); ++rep_) {
        pg8::Gemm g{H, Wup_t, SEQ, NUP, DM}; pg8::StaticOrder S; S.init(SEQ, NUP, G_, bid);
        pg8::EpiBf16<0> E{U, NUP};
        pg8::gemm_phase<pg8::EpiBf16<0>, pg8::StaticOrder, true, true>((LAS unsigned char*)lds, g, S, E);
#if TAILS
        { TIDS; constexpr int NWG = (SEQ / 256) * (NUP / 256); const int R = (NWG + G_ - 1) / G_, thr = NWG - (R - 1) * G_, NL = R * G_ - NWG;
          LAS float* scr = (LAS float*)((LAS unsigned char*)lds + 32768 + wave * 8448);
          constexpr int I_DOWN = 88 * 64;
          const int lw = NL > 0 ? (bid - thr) * 8 + wave : gw, nlw = NL > 0 ? NL * 8 : NGW;
          if (NL == 0 || bid >= thr)
              for (int it = lw; it < I_DOWN; it += nlw) p0_transpose_item(w_down, DFF, DM, Wdown_t, scr, it, lane); }
#endif
        __syncthreads();
    }
    SEAM(8);
    for (int rep_ = 0; rep_ < (IN(9) ? 1 + ((REPMASK >> 9) & 1) : 0); ++rep_) { TIDS;
        for (int it = bid * 512 + tid; it < 704 * 512; it += G_ * 512) conv_gate_item(U, convw, convb, ACT, it);
    }
    SEAM(9);
    for (int rep_ = 0; rep_ < (IN(10) ? 1 : 0); ++rep_) {
        pg8::Gemm g{ACT, Wdown_t, SEQ, DM, DFF}; pg8::StaticOrder S; S.init(SEQ, DM, G_, bid);
        if (G_ == 256 && FUSE_NORM) {
            pg8::EpiResidNorm E{outp, outp, modx + 10240, normf, pg8::RowStats{(float*)(a.ws + WS_SLOT2), (unsigned*)(a.ws + WS_CNT2)}};
            pg8::gemm_phase<pg8::EpiResidNorm, pg8::StaticOrder, false, true>((LAS unsigned char*)lds, g, S, E);
        } else {
            pg8::EpiResid E{outp, outp, modx + 10240};
            pg8::gemm_phase<pg8::EpiResid, pg8::StaticOrder, true, true>((LAS unsigned char*)lds, g, S, E);
        }
    }
    if (!(G_ == 256 && FUSE_NORM)) {
    SEAM(10);
    for (int rep_ = 0; rep_ < (IN(11) ? 1 : 0); ++rep_) { TIDS;
        for (int m = gw; m < SEQ; m += NGW) final_norm_row(outp + (size_t)m * DM, normf, lane);
    }
    }
#undef IN
#undef SEAM
#undef x_in
#undef cvec
#undef ctx
#undef cctx
#undef wmod
#undef bmod
#undef norm1
#undef w_in
#undef qn
#undef kn
#undef b_ig
#undef b_fg
#undef mnorm
#undef w_out
#undef norm2
#undef w_up
#undef convw
#undef convb
#undef w_down
#undef normf
#undef outp
#undef modx
#undef modc
#undef BL
#undef Gt
#undef Wdown_t
#undef Win_t
#undef Wout_t
#undef Wup_t
#undef H
#undef MIX
#undef ACT
#undef P
#undef ST
#undef U
}

#ifndef N_LAUNCH_MODE
#define N_LAUNCH_MODE 1
#endif
extern "C" void kernel_launch(void* const* d_in, const int* in_sizes, int n_in, void* d_out, int out_size, void* d_ws, size_t ws_size, hipStream_t stream) {
    static int grid = 0;
    if (grid == 0) {
        if (n_in != 20 || ws_size < WS_END) { fprintf(stderr, "kernel_launch: unexpected n_in %d / ws %zu\n", n_in, ws_size); grid = -1; return; }
        int dev = 0, cus = 0, per_cu = 0;
        hipGetDevice(&dev); hipDeviceGetAttribute(&cus, hipDeviceAttributeMultiprocessorCount, dev);
        hipFuncSetAttribute((const void*)fwd_kernel, hipFuncAttributeMaxDynamicSharedMemorySize, LDS_BYTES);
        hipOccupancyMaxActiveBlocksPerMultiprocessor(&per_cu, (const void*)fwd_kernel, 512, LDS_BYTES);
        if (per_cu < 1) { fprintf(stderr, "kernel_launch: occupancy query says %d blocks/CU\n", per_cu); per_cu = 1; }
        if (per_cu > 1) per_cu = 1;
        grid = cus * per_cu;
    }
    if (grid < 0) return;
    Args a{};
    for (int i = 0; i < 20; ++i) a.in[i] = (const float*)d_in[i];
    a.out = (float*)d_out; a.ws = (unsigned char*)d_ws;
#if N_LAUNCH_MODE == 1
    a.ph_lo = 0; a.ph_hi = NPHASE; a.coop = 1;
    hipMemsetAsync((char*)d_ws + WS_BAR, 0, BAR_BYTES, stream);
    void* args[] = {&a};
    hipError_t e = hipLaunchCooperativeKernel((const void*)fwd_kernel, dim3(grid), dim3(512), args, LDS_BYTES, stream);
    if (e != hipSuccess) fprintf(stderr, "cooperative launch failed: %s (grid %d)\n", hipGetErrorString(e), grid);
#else
    for (int ph = 0; ph < NPHASE; ++ph) { a.ph_lo = ph; a.ph_hi = ph + 1; hipLaunchKernelGGL(fwd_kernel, dim3(grid), dim3(512), LDS_BYTES, stream, a); }
#endif
}
```

```cpp
#include <hip/hip_runtime.h>
#include <hip/hip_cooperative_groups.h>
#include <cstdio>
#include <cstdint>
namespace cg = cooperative_groups;
__device__ __forceinline__ int ltid() { int t = threadIdx.x; asm volatile("" : "+v"(t)); return t; }
namespace pg8 {
#define PG8_LAS __attribute__((address_space(3)))
typedef unsigned short bf16_t;
typedef short bf16x8 __attribute__((ext_vector_type(8)));
typedef float f32x4 __attribute__((ext_vector_type(4)));
typedef unsigned u32x4 __attribute__((ext_vector_type(4)));
constexpr int BM = 256, BK = 64, HALF = 128, HTB = HALF * BK * 2  , STAGE_BYTES = 8 * HTB, NXCD = 8, WGM = 8;

__host__ __device__ __forceinline__ int lds_byte(int r, int c) { const int st = (r >> 4) * 2 + (c >> 5), rr = r & 15, cc = c & 31, ob = rr * 64 + cc * 2; return st * 1024 + (ob ^ (((ob >> 9) & 1) << 5)); }
__host__ __device__ __forceinline__ void stage_rc(int b, int& R, int& C) { const int st = b / 1024, sb = b % 1024, swz = sb ^ (((sb >> 9) & 1) << 5); R = (st >> 1) * 16 + swz / 64; C = (st & 1) * 32 + (swz % 64) / 2; }
__host__ __device__ __forceinline__ int perm32(int rho) { const int n = rho >> 4, i = rho & 15; return 8 * (i >> 2) + 4 * n + (i & 3); }

struct Unit { int pm, pn; };
struct Gemm { const bf16_t* A; const bf16_t* Bt; int M, N, K; int a_rows = 256; };

struct StaticOrder {
    int nM, nN, nwg, G, c;
    __host__ __device__ void init(int M, int N, int G_, int c_) { nM = M / BM; nN = N / BM; nwg = nM * nN; G = G_; c = c_; }
    __host__ __device__ bool next(int i, Unit& u) const {
        const long L = (long)i * G + c; if (L >= nwg) return false;
        int wgid = (int)L; { const int q = nwg / NXCD, r = nwg % NXCD, xcd = wgid % NXCD, off = wgid / NXCD; wgid = (xcd < r ? xcd * (q + 1) : r * (q + 1) + (xcd - r) * q) + off; }
        const int nig = WGM * nN, gid = wgid / nig, fm = gid * WGM, gsz = (nM - fm) < WGM ? (nM - fm) : WGM;
        u.pm = fm + ((wgid % nig) % gsz); u.pn = (wgid % nig) / gsz; return true;
    }
    __device__ __forceinline__ void a_ready(const Unit&) const {}
    __device__ __forceinline__ void done(const Unit&) const {}
};

typedef float f32x2 __attribute__((ext_vector_type(2)));
__device__ __forceinline__ unsigned cvt_pk_bf16(float lo, float hi) { typedef __bf16 bf16x2_ __attribute__((ext_vector_type(2))); const f32x2 v = {lo, hi}; const bf16x2_ b = __builtin_convertvector(v, bf16x2_); return __builtin_bit_cast(unsigned, b); }
#ifndef WT_STORES
#define WT_STORES 0
#endif
#if WT_STORES
__device__ __forceinline__ void st16_wt(void* p, u32x4 v) { asm volatile("global_store_dwordx4 %0, %1, off sc0 sc1" :: "v"(p), "v"(v) : "memory"); }
#else
__device__ __forceinline__ void st16_wt(void* p, u32x4 v) { *(u32x4*)p = v; }
#endif
template <int ACT> struct EpiBf16 {
    static constexpr bool PERM = true, AFTER_DRAIN = false;
    bf16_t* O; int ldc;
    __device__ __forceinline__ void operator()(const f32x4 (&acc)[2][2][4][2], const Unit& u, int wr, int wc, int fr, int fq) const {
        const int row0 = u.pm * BM + wr * 64 + fr; const int col0 = u.pn * BM + wc * 32 + 8 * fq;
#pragma unroll
        for (int ai = 0; ai < 2; ++ai)
#pragma unroll
            for (int m = 0; m < 4; ++m) { bf16_t* rowp = O + (size_t)(row0 + ai * HALF + m * 16) * ldc + col0;
#pragma unroll
                for (int bj = 0; bj < 2; ++bj) { const f32x4 v0 = acc[ai][bj][m][0], v1 = acc[ai][bj][m][1];
                    u32x4 w; w.x = cvt_pk_bf16(v0[0], v0[1]); w.y = cvt_pk_bf16(v0[2], v0[3]); w.z = cvt_pk_bf16(v1[0], v1[1]); w.w = cvt_pk_bf16(v1[2], v1[3]);
                    st16_wt(rowp + bj * HALF, w); } }
    }
};
struct EpiInProj {
    static constexpr bool PERM = true, AFTER_DRAIN = false;
    bf16_t* P; float* G;
    __device__ __forceinline__ void operator()(const f32x4 (&acc)[2][2][4][2], const Unit& u, int wr, int wc, int fr, int fq) const {
        const int row0 = u.pm * BM + wr * 64 + fr; const int pn = u.pn;
        if (pn == 18) {
            if (wc == 0 && fq < 2) {
#pragma unroll
                for (int ai = 0; ai < 2; ++ai)
#pragma unroll
                    for (int m = 0; m < 4; ++m) { float* gp = G + (size_t)(row0 + ai * HALF + m * 16) * 16 + 8 * fq;
                        *(f32x4*)(gp) = acc[ai][0][m][0]; *(f32x4*)(gp + 4) = acc[ai][0][m][1]; }
            }
            return;
        }
        const int col0 = pn * BM + wc * 32 + 8 * fq;
        const int mode = (pn == 8 || pn == 9) ? 1 : (pn >= 14 ? 2 : 0);
#pragma unroll
        for (int ai = 0; ai < 2; ++ai)
#pragma unroll
            for (int m = 0; m < 4; ++m) { bf16_t* rowp = P + (size_t)(row0 + ai * HALF + m * 16) * 4608 + col0;
#pragma unroll
                for (int bj = 0; bj < 2; ++bj) { f32x4 v0 = acc[ai][bj][m][0], v1 = acc[ai][bj][m][1];
                    if (mode == 1) { v0 = v0 * 0.08838834764831845f; v1 = v1 * 0.08838834764831845f; }
                    else if (mode == 2) {
#pragma unroll
                        for (int j = 0; j < 4; ++j) { v0[j] = __builtin_amdgcn_rcpf(1.0f + __builtin_amdgcn_exp2f(-1.4426950408889634f * v0[j])); v1[j] = __builtin_amdgcn_rcpf(1.0f + __builtin_amdgcn_exp2f(-1.4426950408889634f * v1[j])); } }
                    u32x4 w; w.x = cvt_pk_bf16(v0[0], v0[1]); w.y = cvt_pk_bf16(v0[2], v0[3]); w.z = cvt_pk_bf16(v1[0], v1[1]); w.w = cvt_pk_bf16(v1[2], v1[3]);
                    *(u32x4*)(rowp + bj * HALF) = w; } }
    }
};
struct EpiResid {
    static constexpr bool PERM = false, AFTER_DRAIN = false;
    const float* base; float* out; const float* gate;
    __device__ __forceinline__ void operator()(const f32x4 (&acc)[2][2][4][2], const Unit& u, int wr, int wc, int fr, int fq) const {
        const int row0 = u.pm * BM + wr * 64 + fr; const int col0 = u.pn * BM + wc * 32 + 4 * fq;
#pragma unroll
        for (int bj = 0; bj < 2; ++bj)
#pragma unroll
            for (int n = 0; n < 2; ++n) { const f32x4 g = *(const f32x4*)(gate + col0 + bj * HALF + n * 16);
#pragma unroll
                for (int ai = 0; ai < 2; ++ai)
#pragma unroll
                    for (int m = 0; m < 4; ++m) { const size_t off = (size_t)(row0 + ai * HALF + m * 16) * 2048 + col0 + bj * HALF + n * 16;
                        const f32x4 b = *(const f32x4*)(base + off); { const f32x4 o_ = b + g * acc[ai][bj][m][n]; st16_wt(out + off, __builtin_bit_cast(u32x4, o_)); } } }
    }
};
struct RowStats {
    float* slots;
    unsigned* cnt;
    __device__ __forceinline__ void run(const f32x4 (&v)[2][2][4][2], const Unit& u, int wr, int wc, int fr, int fq, PG8_LAS unsigned char* lds, int wid, int lane) const {
        PG8_LAS float* Pp = (PG8_LAS float*)lds;
        PG8_LAS float* S = (PG8_LAS float*)(lds + 4096);
#pragma unroll
        for (int ai = 0; ai < 2; ++ai)
#pragma unroll
            for (int m = 0; m < 4; ++m) { float s = 0.f;
#pragma unroll
                for (int bj = 0; bj < 2; ++bj)
#pragma unroll
                    for (int n = 0; n < 2; ++n) { const f32x4 x = v[ai][bj][m][n]; s += (x[0] * x[0] + x[1] * x[1]) + (x[2] * x[2] + x[3] * x[3]); }
                s += __shfl_xor(s, 16); s += __shfl_xor(s, 32);
                if (fq == 0) Pp[(ai * HALF + wr * 64 + m * 16 + fr) * 4 + wc] = s; }
        asm volatile("s_waitcnt lgkmcnt(0)" ::: "memory"); __builtin_amdgcn_s_barrier(); asm volatile("" ::: "memory");
        const int row = wid * 32 + (lane & 31);
        if (lane < 32) { const float tot = (Pp[row * 4 + 0] + Pp[row * 4 + 1]) + (Pp[row * 4 + 2] + Pp[row * 4 + 3]);
            __hip_atomic_store(slots + (size_t)(u.pm * BM + row) * 8 + u.pn, tot, __ATOMIC_RELAXED, __HIP_MEMORY_SCOPE_AGENT); }
        asm volatile("s_waitcnt vmcnt(0)" ::: "memory");
        if (lane == 0) __hip_atomic_fetch_add(cnt + 64 * u.pm, 1u, __ATOMIC_RELAXED, __HIP_MEMORY_SCOPE_AGENT);
        if (wid == 0) { unsigned sp = 0;
            for (;;) { if ((unsigned)__builtin_amdgcn_readfirstlane(__hip_atomic_load(cnt + 64 * u.pm, __ATOMIC_RELAXED, __HIP_MEMORY_SCOPE_AGENT)) >= 64u) break;
                __builtin_amdgcn_s_sleep(2); if (++sp > (1u << 22)) break; }
            __builtin_amdgcn_fence(__ATOMIC_ACQUIRE, "agent"); }
        asm volatile("s_waitcnt vmcnt(0) lgkmcnt(0)" ::: "memory"); __builtin_amdgcn_s_barrier(); asm volatile("" ::: "memory");
        if (lane < 32) { const float* sl = slots + (size_t)(u.pm * BM + row) * 8; float q = 0.f;
#pragma unroll
            for (int t = 0; t < 8; ++t) q += __hip_atomic_load(sl + t, __ATOMIC_RELAXED, __HIP_MEMORY_SCOPE_AGENT);
            S[row] = rsqrtf(q * (1.0f / 2048.0f) + 1e-6f); }
        asm volatile("s_waitcnt lgkmcnt(0)" ::: "memory"); __builtin_amdgcn_s_barrier(); asm volatile("" ::: "memory");
    }
};
struct EpiResidNorm {
    static constexpr bool PERM = false, AFTER_DRAIN = true;
    const float* base; float* out; const float* gate; const float* gain; RowStats st;
    __device__ __forceinline__ void operator()(const f32x4 (&)[2][2][4][2], const Unit&, int, int, int, int) const {}
    __device__ __forceinline__ void fused(f32x4 (&acc)[2][2][4][2], const Unit& u, int wr, int wc, int fr, int fq, PG8_LAS unsigned char* lds, int wid, int lane) const {
        const int row0 = u.pm * BM + wr * 64 + fr; const int col0 = u.pn * BM + wc * 32 + 4 * fq; size_t off0 = (size_t)row0 * 2048 + col0;
#pragma unroll
        for (int bj = 0; bj < 2; ++bj)
#pragma unroll
            for (int n = 0; n < 2; ++n) { const f32x4 g = *(const f32x4*)(gate + col0 + bj * HALF + n * 16);
#pragma unroll
                for (int ai = 0; ai < 2; ++ai)
#pragma unroll
                    for (int m = 0; m < 4; ++m) { const size_t off = off0 + (size_t)((ai * HALF + m * 16) * 2048 + bj * HALF + n * 16);
                        acc[ai][bj][m][n] = __builtin_nontemporal_load((const f32x4*)(base + off)) + g * acc[ai][bj][m][n];
                        asm volatile("" : "+v"(acc[ai][bj][m][n]));
                        if (m == 3) asm volatile("" ::: "memory"); } }
        st.run(acc, u, wr, wc, fr, fq, lds, wid, lane);
        asm volatile("" : "+v"(off0));
        const PG8_LAS float* S = (const PG8_LAS float*)(lds + 4096);
#pragma unroll
        for (int bj = 0; bj < 2; ++bj)
#pragma unroll
            for (int n = 0; n < 2; ++n) { const f32x4 gn = *(const f32x4*)(gain + col0 + bj * HALF + n * 16);
#pragma unroll
                for (int ai = 0; ai < 2; ++ai)
#pragma unroll
                    for (int m = 0; m < 4; ++m) { const int r = ai * HALF + wr * 64 + m * 16 + fr; const size_t off = off0 + (size_t)((ai * HALF + m * 16) * 2048 + bj * HALF + n * 16);
                        { const f32x4 o_ = acc[ai][bj][m][n] * S[r] * gn; __builtin_nontemporal_store(o_, (f32x4*)(out + off)); } }
                asm volatile("" ::: "memory"); }
    }
};
struct EpiResidNormMod {
    static constexpr bool PERM = false, AFTER_DRAIN = true;
    const float* base; float* out; const float* gate; const float* gain; const float* sh; const float* sc; bf16_t* hn; RowStats st;
    __device__ __forceinline__ void operator()(const f32x4 (&)[2][2][4][2], const Unit&, int, int, int, int) const {}
    __device__ __forceinline__ void fused(f32x4 (&acc)[2][2][4][2], const Unit& u, int wr, int wc, int fr, int fq, PG8_LAS unsigned char* lds, int wid, int lane) const {
        typedef unsigned u32x2_ __attribute__((ext_vector_type(2)));
        const int row0 = u.pm * BM + wr * 64 + fr; const int col0 = u.pn * BM + wc * 32 + 4 * fq; size_t off0 = (size_t)row0 * 2048 + col0;
#pragma unroll
        for (int bj = 0; bj < 2; ++bj)
#pragma unroll
            for (int n = 0; n < 2; ++n) { const f32x4 g = *(const f32x4*)(gate + col0 + bj * HALF + n * 16);
#pragma unroll
                for (int ai = 0; ai < 2; ++ai)
#pragma unroll
                    for (int m = 0; m < 4; ++m) { const size_t off = off0 + (size_t)((ai * HALF + m * 16) * 2048 + bj * HALF + n * 16);
                        const f32x4 x1 = __builtin_nontemporal_load((const f32x4*)(base + off)) + g * acc[ai][bj][m][n]; acc[ai][bj][m][n] = x1; __builtin_nontemporal_store(x1, (f32x4*)(out + off));
                        asm volatile("" : "+v"(acc[ai][bj][m][n]));
                        if (m == 3) asm volatile("" ::: "memory"); } }
        st.run(acc, u, wr, wc, fr, fq, lds, wid, lane);
        asm volatile("" : "+v"(off0));
        const PG8_LAS float* S = (const PG8_LAS float*)(lds + 4096);
#pragma unroll
        for (int bj = 0; bj < 2; ++bj)
#pragma unroll
            for (int n = 0; n < 2; ++n) { const int c = col0 + bj * HALF + n * 16; const f32x4 gn = *(const f32x4*)(gain + c), s1 = *(const f32x4*)(sc + c) + 1.0f, s0 = *(const f32x4*)(sh + c);
#pragma unroll
                for (int ai = 0; ai < 2; ++ai)
#pragma unroll
                    for (int m = 0; m < 4; ++m) { const int r = ai * HALF + wr * 64 + m * 16 + fr; const size_t off = off0 + (size_t)((ai * HALF + m * 16) * 2048 + bj * HALF + n * 16);
                        const f32x4 y = (acc[ai][bj][m][n] * S[r] * gn) * s1 + s0; u32x2_ w; w.x = cvt_pk_bf16(y[0], y[1]); w.y = cvt_pk_bf16(y[2], y[3]); *(u32x2_*)(hn + off) = w; }
                asm volatile("" ::: "memory"); }
    }
};
template <class Epi, class Sched, bool ALIGN_EPI = false, bool SP2 = false>
__device__ __forceinline__ void gemm_phase(PG8_LAS unsigned char* lds, const Gemm g, const Sched& S, const Epi& E) {
    const int tid = ltid(), wid = __builtin_amdgcn_readfirstlane(tid >> 6), lane = tid & 63, wr = wid >> 2, wc = wid & 3, fr = lane & 15, fq = lane >> 4;
    const int K = g.K, nt = K / BK;
    unsigned voffA[2], voffB[2];
#pragma unroll
    for (int i = 0; i < 2; ++i) { int R, C; stage_rc(tid * 16 + i * 8192, R, C); const int Rb = Epi::PERM ? ((R & ~31) + perm32(R & 31)) : R;
        voffA[i] = (unsigned)(R * K + C) * 2u; voffB[i] = (unsigned)(Rb * K + C) * 2u; }
    const size_t kstep = (size_t)(BK * 2);
    const size_t hstep = (size_t)HALF * K * 2;
    const size_t tstep = 2 * hstep; const size_t tstepA = (size_t)g.a_rows * K * 2;
    const unsigned ldsw = (unsigned)wid * 1024u;
    const int aoff = lds_byte(wr * 64 + fr, fq * 8), boff = lds_byte(wc * 32 + fr, fq * 8);
#define PG8_SA(b, h) (((b) * 2 + (h)) * HTB)
#define PG8_SB(b, h) ((4 + (b) * 2 + (h)) * HTB)
#define PG8_STAGE(bufoff, gbase, voff) do { _Pragma("unroll") for (int _i = 0; _i < 2; ++_i) \
        __builtin_amdgcn_global_load_lds((const unsigned*)((const char*)(gbase) + (voff)[_i]), (PG8_LAS unsigned*)(lds + (bufoff) + ldsw + _i * 8192), 16, 0, 0); } while (0)
#define PG8_LDA(dst, b, h) do { _Pragma("unroll") for (int m = 0; m < 4; ++m) _Pragma("unroll") for (int k = 0; k < 2; ++k) dst[m][k] = *(const PG8_LAS bf16x8*)(lds + PG8_SA(b, h) + aoff + m * 2048 + k * 1024); } while (0)
#define PG8_LDB(dst, b, h) do { _Pragma("unroll") for (int n = 0; n < 2; ++n) _Pragma("unroll") for (int k = 0; k < 2; ++k) dst[n][k] = *(const PG8_LAS bf16x8*)(lds + PG8_SB(b, h) + boff + n * 2048 + k * 1024); } while (0)
#define PG8_MMA(ai, bj, At, Bt) do { __builtin_amdgcn_s_setprio(1); _Pragma("unroll") for (int m = 0; m < 4; ++m) _Pragma("unroll") for (int n = 0; n < 2; ++n) _Pragma("unroll") for (int k = 0; k < 2; ++k) \
        acc[ai][bj][m][n] = __builtin_amdgcn_mfma_f32_16x16x32_bf16(Bt[n][k], At[m][k], acc[ai][bj][m][n], 0, 0, 0); __builtin_amdgcn_s_setprio(0); } while (0)
#define PG8_WAIT_V(n) asm volatile("s_waitcnt vmcnt(" #n ")" ::: "memory")
#define PG8_WAIT_L(n) asm volatile("s_waitcnt lgkmcnt(" #n ")" ::: "memory")
#define PG8_BAR __builtin_amdgcn_s_barrier()
#define PG8_SCHED __builtin_amdgcn_sched_barrier(0)
    Unit cur, nxt; int ui = 0;
    if (!S.next(0, cur)) return;
    f32x4 acc[2][2][4][2];
#pragma unroll
    for (int a = 0; a < 2; ++a)
#pragma unroll
        for (int b = 0; b < 2; ++b)
#pragma unroll
            for (int m = 0; m < 4; ++m)
#pragma unroll
                for (int n = 0; n < 2; ++n) acc[a][b][m][n] = (f32x4){0.f, 0.f, 0.f, 0.f};
    bf16x8 At[4][2], B0[2][2], B1[2][2];
    const char* cA = (const char*)g.A + (size_t)cur.pm * tstepA; const char* cB = (const char*)g.Bt + (size_t)cur.pn * tstep;
    S.a_ready(cur);
    if constexpr (SP2) {
        PG8_STAGE(PG8_SB(0, 0), cB, voffB); PG8_STAGE(PG8_SB(0, 1), cB + hstep, voffB); PG8_STAGE(PG8_SA(0, 0), cA, voffA); PG8_STAGE(PG8_SA(0, 1), cA + hstep, voffA);
        if (wr == 1) PG8_BAR;
        PG8_WAIT_V(2); PG8_BAR;
        PG8_STAGE(PG8_SB(1, 0), cB + kstep, voffB); PG8_STAGE(PG8_SA(1, 0), cA + kstep, voffA); PG8_STAGE(PG8_SB(1, 1), cB + hstep + kstep, voffB);
        PG8_WAIT_V(6); PG8_BAR;
    } else {
        PG8_STAGE(PG8_SB(0, 0), cB, voffB); PG8_STAGE(PG8_SA(0, 0), cA, voffA); PG8_STAGE(PG8_SB(0, 1), cB + hstep, voffB); PG8_STAGE(PG8_SA(0, 1), cA + hstep, voffA);
        if (wr == 1) PG8_BAR;
        PG8_WAIT_V(4); PG8_BAR;
        PG8_STAGE(PG8_SB(1, 0), cB + kstep, voffB); PG8_STAGE(PG8_SA(1, 0), cA + kstep, voffA); PG8_STAGE(PG8_SB(1, 1), cB + hstep + kstep, voffB);
        PG8_WAIT_V(6); PG8_BAR;
    }
    for (;;) {
        const bool has_next = S.next(ui + 1, nxt);
        const char* nA = has_next ? (const char*)g.A + (size_t)nxt.pm * tstepA : cA; const char* nB = has_next ? (const char*)g.Bt + (size_t)nxt.pn * tstep : cB;
        for (int t = 0; t < nt; t += 2) {
            const bool last = (t == nt - 2);
            const char* a1 = cA + (size_t)(t + 1) * kstep;
            const char* a2 = last ? nA : cA + (size_t)(t + 2) * kstep; const char* b2 = last ? nB : cB + (size_t)(t + 2) * kstep;
            const char* a3 = a2 + kstep; const char* b3 = b2 + kstep;
            if (last && has_next) S.a_ready(nxt);
            if constexpr (SP2) {
            PG8_LDB(B0, 0, 0); PG8_LDB(B1, 0, 1); PG8_SCHED; PG8_LDA(At, 0, 0); PG8_STAGE(PG8_SA(1, 1), a1 + hstep, voffA);
            PG8_WAIT_V(8); PG8_WAIT_L(0); PG8_BAR; PG8_MMA(0, 0, At, B0); PG8_MMA(0, 1, At, B1); PG8_BAR; PG8_SCHED;
            PG8_LDA(At, 0, 1); PG8_STAGE(PG8_SB(0, 0), b2, voffB); PG8_STAGE(PG8_SB(0, 1), b2 + hstep, voffB); PG8_STAGE(PG8_SA(0, 0), a2, voffA);
            PG8_WAIT_V(8); PG8_WAIT_L(0); PG8_BAR; PG8_MMA(1, 0, At, B0); PG8_MMA(1, 1, At, B1); PG8_BAR; PG8_SCHED;
            PG8_LDB(B0, 1, 0); PG8_LDB(B1, 1, 1); PG8_SCHED; PG8_LDA(At, 1, 0); PG8_STAGE(PG8_SA(0, 1), a2 + hstep, voffA);
            PG8_WAIT_V(8); PG8_WAIT_L(0); PG8_BAR; PG8_MMA(0, 0, At, B0); PG8_MMA(0, 1, At, B1); PG8_BAR; PG8_SCHED;
            PG8_LDA(At, 1, 1); PG8_STAGE(PG8_SB(1, 0), b3, voffB); PG8_STAGE(PG8_SB(1, 1), b3 + hstep, voffB); PG8_STAGE(PG8_SA(1, 0), a3, voffA);
            PG8_WAIT_V(8); PG8_WAIT_L(0); PG8_BAR; PG8_MMA(1, 0, At, B0); PG8_MMA(1, 1, At, B1); PG8_BAR; PG8_SCHED;
            } else {
            PG8_LDB(B0, 0, 0); PG8_SCHED; PG8_LDA(At, 0, 0); PG8_STAGE(PG8_SA(1, 1), a1 + hstep, voffA);
            PG8_WAIT_L(8); PG8_BAR; PG8_WAIT_L(0); PG8_MMA(0, 0, At, B0); PG8_BAR; PG8_SCHED;
            PG8_LDB(B1, 0, 1); PG8_STAGE(PG8_SB(0, 0), b2, voffB);
            PG8_BAR; PG8_WAIT_L(0); PG8_MMA(0, 1, At, B1); PG8_BAR;
            PG8_LDA(At, 0, 1); PG8_STAGE(PG8_SA(0, 0), a2, voffA);
            PG8_BAR; PG8_WAIT_L(0); PG8_MMA(1, 0, At, B0); PG8_BAR; PG8_SCHED;
            PG8_STAGE(PG8_SB(0, 1), b2 + hstep, voffB);
            PG8_WAIT_V(6); PG8_BAR; PG8_MMA(1, 1, At, B1); PG8_BAR;
            PG8_LDB(B0, 1, 0); PG8_SCHED; PG8_LDA(At, 1, 0); PG8_STAGE(PG8_SA(0, 1), a2 + hstep, voffA);
            PG8_WAIT_L(8); PG8_BAR; PG8_WAIT_L(0); PG8_MMA(0, 0, At, B0); PG8_BAR; PG8_SCHED;
            PG8_LDB(B1, 1, 1); PG8_STAGE(PG8_SB(1, 0), b3, voffB);
            PG8_BAR; PG8_WAIT_L(0); PG8_MMA(0, 1, At, B1); PG8_BAR;
            PG8_LDA(At, 1, 1); PG8_STAGE(PG8_SA(1, 0), a3, voffA);
            PG8_BAR; PG8_WAIT_L(0); PG8_MMA(1, 0, At, B0); PG8_BAR; PG8_SCHED;
            PG8_STAGE(PG8_SB(1, 1), b3 + hstep, voffB);
            PG8_WAIT_V(6); PG8_BAR; PG8_MMA(1, 1, At, B1); PG8_BAR;
            }
        }
        if constexpr (ALIGN_EPI) { if (wr == 0) PG8_BAR; }
        if constexpr (!Epi::AFTER_DRAIN) { E(acc, cur, wr, wc, fr, fq); S.done(cur); }
        if (!has_next) break;
#pragma unroll
        for (int a = 0; a < 2; ++a)
#pragma unroll
            for (int b = 0; b < 2; ++b)
#pragma unroll
                for (int m = 0; m < 4; ++m)
#pragma unroll
                    for (int n = 0; n < 2; ++n) acc[a][b][m][n] = (f32x4){0.f, 0.f, 0.f, 0.f};
        cur = nxt; cA = nA; cB = nB; ++ui;
        if constexpr (ALIGN_EPI) { if (wr == 1) PG8_BAR; }
    }
    PG8_WAIT_V(0);
    if constexpr (!ALIGN_EPI) { if (wr == 0) PG8_BAR; }
    PG8_BAR;
    if constexpr (Epi::AFTER_DRAIN) { E.fused(acc, cur, wr, wc, fr, fq, lds, wid, lane); S.done(cur); }
#undef PG8_SA
#undef PG8_SB
#undef PG8_STAGE
#undef PG8_LDA
#undef PG8_LDB
#undef PG8_MMA
#undef PG8_WAIT_V
#undef PG8_WAIT_L
#undef PG8_BAR
#undef PG8_SCHED
}
}
namespace att {
typedef unsigned short bf16;
constexpr int   D = 128, NW = 8, QBLK = 32, KVBLK = 64;
constexpr float SCALE = 0.088388347648318440f;
constexpr float THR = 8.f;
constexpr int LDQ = 4608, LDK = 4608, LDO = 2048;
constexpr size_t SHM_V = KVBLK * D * 2, SHM_K = KVBLK * D * 2, SHM_ATTN = 2 * SHM_V + 2 * SHM_K + NW * 64 * 4;
using bf16x8 = __attribute__((ext_vector_type(8))) short;
using s16x4  = __attribute__((ext_vector_type(4))) short;
using f32x16 = __attribute__((ext_vector_type(16))) float;
using u32x4  = __attribute__((ext_vector_type(4))) unsigned;
#define KSWZ(row, colB) ((row) * 256 + ((colB) ^ (((row) & 7) << 4)))
#define SBAR() __builtin_amdgcn_sched_barrier(0)
__device__ __forceinline__ int crow(int r, int hi) { return (r & 3) + 8 * (r >> 2) + 4 * hi; }
__device__ __forceinline__ unsigned cvtpk(float lo, float hi) {
  unsigned r; asm volatile("v_cvt_pk_bf16_f32 %0, %1, %2" : "=v"(r) : "v"(lo), "v"(hi)); return r;
}
__device__ __forceinline__ bf16x8 ld8(const bf16* p) { return *reinterpret_cast<const bf16x8*>(p); }
__device__ __forceinline__ void partialSM(f32x16& p0, f32x16& p1, float& m_reg, float& mn, float& alpha) {
  constexpr float C = SCALE * 1.4426950408889634f;
  float pmax = p0[0]; for (int r = 1; r < 16; ++r) pmax = fmaxf(pmax, p0[r]); for (int r = 0; r < 16; ++r) pmax = fmaxf(pmax, p1[r]);
  { auto rr = __builtin_amdgcn_permlane32_swap(__float_as_uint(pmax), __float_as_uint(pmax), false, false);
    pmax = fmaxf(__uint_as_float(rr[0]), __uint_as_float(rr[1])); }
  if (__builtin_expect(__all(pmax - m_reg <= THR / SCALE), 1)) { mn = m_reg; alpha = 1.f; }
  else { mn = fmaxf(m_reg, pmax); alpha = __builtin_amdgcn_exp2f((m_reg - mn) * C); m_reg = mn; }
  float mnC = -mn * C;
  for (int r = 0; r < 16; ++r) p0[r] = fmaf(p0[r], C, mnC); for (int r = 0; r < 16; ++r) p1[r] = fmaf(p1[r], C, mnC);
  for (int r = 0; r < 16; ++r) p0[r] = __builtin_amdgcn_exp2f(p0[r]);
}
#define PK4(P, BASE, OUT) do { unsigned a0 = cvtpk(P[BASE + 0], P[BASE + 1]), a1 = cvtpk(P[BASE + 2], P[BASE + 3]);   \
    unsigned b0 = cvtpk(P[BASE + 4], P[BASE + 5]), b1 = cvtpk(P[BASE + 6], P[BASE + 7]);                              \
    auto r0 = __builtin_amdgcn_permlane32_swap(a0, b0, false, false); auto r1 = __builtin_amdgcn_permlane32_swap(a1, b1, false, false); \
    u32x4 w = {r0[0], r1[0], r0[1], r1[1]}; OUT = *reinterpret_cast<bf16x8*>(&w); } while (0)
__device__ __forceinline__ void finishSM(f32x16& p0, f32x16& p1, float alpha, float& l_reg, bf16x8& pa0, bf16x8& pa1, bf16x8& pa2, bf16x8& pa3) {
  for (int r = 0; r < 16; ++r) p1[r] = __builtin_amdgcn_exp2f(p1[r]);
  float ps = 0; for (int r = 0; r < 16; ++r) ps += p0[r]; for (int r = 0; r < 16; ++r) ps += p1[r];
  { auto rr = __builtin_amdgcn_permlane32_swap(__float_as_uint(ps), __float_as_uint(ps), false, false);
    ps = __uint_as_float(rr[0]) + __uint_as_float(rr[1]); }
  l_reg = l_reg * alpha + ps;
  PK4(p0, 0, pa0); PK4(p0, 8, pa1); PK4(p1, 0, pa2); PK4(p1, 8, pa3);
}
__device__ __forceinline__ void qkt(f32x16& p0, f32x16& p1, const bf16* Ks, const bf16x8* qr, int r32, int hi) {
  p0 = f32x16{}; p1 = f32x16{};
  for (int d0 = 0; d0 < 8; ++d0) { int cb = (d0 * 16 + hi * 8) * 2;
    bf16x8 b0 = *reinterpret_cast<const bf16x8*>((const char*)Ks + KSWZ(r32, cb));
    bf16x8 b1 = *reinterpret_cast<const bf16x8*>((const char*)Ks + KSWZ(32 + r32, cb));
    p0 = __builtin_amdgcn_mfma_f32_32x32x16_bf16(b0, qr[d0], p0, 0, 0, 0);
    p1 = __builtin_amdgcn_mfma_f32_32x32x16_bf16(b1, qr[d0], p1, 0, 0, 0); }
}
__device__ __forceinline__ int v_st(int k, int c) { const int kk = (k & ~0xC) | ((k & 4) << 1) | ((k & 8) >> 1); return ((kk >> 3) * 4 + (c >> 5)) * 512 + ((kk & 7) * 32 + (c & 31)) * 2; }
__device__ __forceinline__ int v_rd_base(int lane) { return ((lane & 3) << 3) | (((lane >> 2) & 3) << 6) | (((lane >> 4) & 1) << 5) | (((lane >> 5) & 1) << 8); }
constexpr int v_rd_off(int d0, int ks, int half) { return d0 * 512 + ks * 4096 + half * 2048; }
template <int OFF> __device__ __forceinline__ s16x4 tr_read(int vb) {
  s16x4 r; asm volatile("ds_read_b64_tr_b16 %0, %1 offset:%2" : "=&v"(r) : "v"(vb), "i"(OFF) : "memory"); return r;
}
template <int D0> __device__ __forceinline__ void pv_one(f32x16& od, int vb, bf16x8 pa0, bf16x8 pa1, bf16x8 pa2, bf16x8 pa3) {
  const s16x4 l0 = tr_read<v_rd_off(D0, 0, 0)>(vb), h0 = tr_read<v_rd_off(D0, 0, 1)>(vb), l1 = tr_read<v_rd_off(D0, 1, 0)>(vb), h1 = tr_read<v_rd_off(D0, 1, 1)>(vb);
  const s16x4 l2 = tr_read<v_rd_off(D0, 2, 0)>(vb), h2 = tr_read<v_rd_off(D0, 2, 1)>(vb), l3 = tr_read<v_rd_off(D0, 3, 0)>(vb), h3 = tr_read<v_rd_off(D0, 3, 1)>(vb);
  asm volatile("s_waitcnt lgkmcnt(0)" ::: "memory"); SBAR();
#define PK(L, H) (bf16x8){L[0], L[1], L[2], L[3], H[0], H[1], H[2], H[3]}
  od = __builtin_amdgcn_mfma_f32_32x32x16_bf16(pa0, PK(l0, h0), od, 0, 0, 0);
  od = __builtin_amdgcn_mfma_f32_32x32x16_bf16(pa1, PK(l1, h1), od, 0, 0, 0);
  od = __builtin_amdgcn_mfma_f32_32x32x16_bf16(pa2, PK(l2, h2), od, 0, 0, 0);
  od = __builtin_amdgcn_mfma_f32_32x32x16_bf16(pa3, PK(l3, h3), od, 0, 0, 0);
#undef PK
}
__device__ __forceinline__ void pv_d0(f32x16* o, int vb, bf16x8 pa0, bf16x8 pa1, bf16x8 pa2, bf16x8 pa3) {
  pv_one<0>(o[0], vb, pa0, pa1, pa2, pa3); pv_one<1>(o[1], vb, pa0, pa1, pa2, pa3); pv_one<2>(o[2], vb, pa0, pa1, pa2, pa3); pv_one<3>(o[3], vb, pa0, pa1, pa2, pa3);
}
__device__ __forceinline__ void attn_dense_body(const bf16* __restrict__ Qb, const bf16* __restrict__ Kh, const bf16* __restrict__ Vh,
                                                bf16* __restrict__ Ob, int seq, char* lds) {
  const int tid = ltid(), wid = tid >> 6, lane = tid & 63, r32 = lane & 31, hi = lane >> 5;
  bf16* V_lds = (bf16*)lds; bf16* K_lds = (bf16*)(lds + 2 * SHM_V);
  float* ws = (float*)(lds + 2 * SHM_V + 2 * SHM_K) + wid * 64; float* li_l = ws; float* al_l = ws + 32;
  float m_reg = -1e30f, l_reg = 0; f32x16 o[4] = {}; bf16x8 qr[8];
  const bf16* Qw = Qb + (long)(wid * QBLK + r32) * LDQ + hi * 8;
#pragma unroll
  for (int d0 = 0; d0 < 8; ++d0) qr[d0] = ld8(Qw + d0 * 16);
  const int sr = tid >> 4, sc = (tid & 15) * 8, vst0 = v_st(sr, sc), vst1 = v_st(32 + sr, sc);
  const int vb0 = (int)(uintptr_t)V_lds + v_rd_base(lane);
  struct { bf16x8 vs0, vs1, ks0, ks1; } sr_[1];
#define SLOAD(i, k0) do { sr_[i].vs0 = ld8(&Vh[(long)((k0) + sr) * LDK + sc]); sr_[i].vs1 = ld8(&Vh[(long)((k0) + 32 + sr) * LDK + sc]); \
    sr_[i].ks0 = ld8(&Kh[(long)((k0) + sr) * LDK + sc]); sr_[i].ks1 = ld8(&Kh[(long)((k0) + 32 + sr) * LDK + sc]); } while (0)
#define SWRITE(b, i) do { *(bf16x8*)((char*)V_lds + (b) * SHM_V + vst0) = sr_[i].vs0;          \
    *(bf16x8*)((char*)V_lds + (b) * SHM_V + vst1) = sr_[i].vs1; int kc = sc * 2;               \
    *(bf16x8*)((char*)K_lds + (b) * SHM_K + KSWZ(sr, kc)) = sr_[i].ks0;                       \
    *(bf16x8*)((char*)K_lds + (b) * SHM_K + KSWZ(32 + sr, kc)) = sr_[i].ks1; } while (0)
#define SWAIT() do { asm volatile("s_waitcnt vmcnt(0)" ::: "memory"); } while (0)
#define RESC(a) do { if (__any((a) < 1.f)) { if (hi == 0) al_l[r32] = (a); asm volatile("s_waitcnt lgkmcnt(0)" ::: "memory"); \
    for (int d = 0; d < 4; ++d) for (int r = 0; r < 16; ++r) o[d][r] *= al_l[crow(r, hi)]; } } while (0)
  f32x16 pA0, pA1, pB0, pB1; float mnA, mnB, alA, alB; bf16x8 pa0, pa1, pa2, pa3; const int NT = seq / KVBLK;
  constexpr int SE = 0, SO = 0;
  SLOAD(SE, 0); asm volatile("s_waitcnt vmcnt(0)" ::: "memory"); SWRITE(0, SE); __syncthreads();
  qkt(pA0, pA1, K_lds, qr, r32, hi); partialSM(pA0, pA1, m_reg, mnA, alA);
  SLOAD(SO, KVBLK);
  SWAIT(); SWRITE(1, SO); __syncthreads();
  for (int j = 1; j + 1 < NT; j += 2) {
    SBAR(); qkt(pB0, pB1, (bf16*)((char*)K_lds + SHM_K), qr, r32, hi);
    finishSM(pA0, pA1, alA, l_reg, pa0, pa1, pa2, pa3); SBAR();
    SLOAD(SO, (j + 1) * KVBLK); SBAR();
    pv_d0(o, vb0, pa0, pa1, pa2, pa3); partialSM(pB0, pB1, m_reg, mnB, alB);
    __syncthreads(); SWAIT(); SWRITE(0, SE);
    RESC(alB); __syncthreads();
    SBAR(); qkt(pA0, pA1, K_lds, qr, r32, hi);
    finishSM(pB0, pB1, alB, l_reg, pa0, pa1, pa2, pa3); SBAR();
    SLOAD(SE, (j + 2) * KVBLK); SBAR();
    pv_d0(o, vb0 + (int)SHM_V, pa0, pa1, pa2, pa3); partialSM(pA0, pA1, m_reg, mnA, alA);
    __syncthreads(); SWAIT(); SWRITE(1, SO);
    RESC(alA); __syncthreads();
  }
  SBAR(); qkt(pB0, pB1, (bf16*)((char*)K_lds + SHM_K), qr, r32, hi);
  finishSM(pA0, pA1, alA, l_reg, pa0, pa1, pa2, pa3); SBAR();
  pv_d0(o, vb0, pa0, pa1, pa2, pa3); partialSM(pB0, pB1, m_reg, mnB, alB);
  __syncthreads(); RESC(alB);
  finishSM(pB0, pB1, alB, l_reg, pa0, pa1, pa2, pa3); SBAR();
  pv_d0(o, vb0 + (int)SHM_V, pa0, pa1, pa2, pa3);
  if (hi == 0) li_l[r32] = l_reg; asm volatile("s_waitcnt lgkmcnt(0)" ::: "memory");
  float rli[16];
#pragma unroll
  for (int r = 0; r < 16; ++r) rli[r] = __builtin_amdgcn_rcpf(li_l[crow(r, hi)]);
  bf16* Ow = Ob + (long)(wid * QBLK) * LDO;
#pragma unroll
  for (int r = 0; r < 16; ++r) { int orow = crow(r, hi);
    for (int d0 = 0; d0 < 4; ++d0) { const float v = o[d0][r] * rli[r]; Ow[(long)orow * LDO + d0 * 32 + r32] = (bf16)(cvtpk(v, v) & 0xffffu); } }
#undef SLOAD
#undef SWRITE
#undef SWAIT
#undef RESC
}
}
#define LAS __attribute__((address_space(3)))
#define XB_TMO      128
#define XB_XCNT(j)  (256  + 64 * (j))
#define XB_XSUB(j)  (1280 + 64 * (j))
#define XB_XGEN(j)  (2304 + 64 * (j))
#define XB_TOP      3328
#define XB_TOPGEN   3392
#define XCD_BAR_WORDS 3456
#define XB_SPIN_CAP (1u << 18)

__device__ __forceinline__ unsigned xb_ld(unsigned* p)              { return __hip_atomic_load(p, __ATOMIC_RELAXED, __HIP_MEMORY_SCOPE_AGENT); }
__device__ __forceinline__ unsigned xb_add(unsigned* p, unsigned v) { return __hip_atomic_fetch_add(p, v, __ATOMIC_RELAXED, __HIP_MEMORY_SCOPE_AGENT); }
__device__ __forceinline__ unsigned xb_xcc_id() { return (unsigned)__builtin_amdgcn_s_getreg((3 << 11) | 20) & 0xFu; }
#define XB_SPIN(cond, bar) do { unsigned _sp = 0; while (cond) { __builtin_amdgcn_s_sleep(1); \
    if ((++_sp & 255u) == 0u) { if (xb_ld(&(bar)[XB_TMO])) break; if (_sp > XB_SPIN_CAP) { atomicAdd(&(bar)[XB_TMO], 1u); break; } } } } while (0)

struct XcdBarrier {
    unsigned* bar; unsigned x;
    volatile LAS unsigned* st;
};

__device__ __forceinline__ XcdBarrier xcd_barrier_post(unsigned* bar, volatile LAS unsigned* st) {
    XcdBarrier b; b.bar = bar; b.x = xb_xcc_id(); b.st = st;
    if (threadIdx.x == 0) (void)xb_add(&bar[XB_XCNT(b.x)], 1u);
    return b;
}
__device__ __forceinline__ void xcd_barrier_complete(unsigned* bar, unsigned x, unsigned& nloc, unsigned& nx) {
    const unsigned G = gridDim.x * gridDim.y * gridDim.z;
    unsigned sum, cnt, mine, sp = 0u;
    for (;;) {
        sum = 0u; cnt = 0u; mine = 0u;
#pragma unroll
        for (unsigned j = 0; j < 16; ++j) { const unsigned c = xb_ld(&bar[XB_XCNT(j)]); sum += c; cnt += (c > 0u) ? 1u : 0u; mine = (j == x) ? c : mine; }
        if (sum == G) break;
        __builtin_amdgcn_s_sleep(1);
        if ((++sp & 255u) == 0u) { if (xb_ld(&bar[XB_TMO])) break; if (sp > XB_SPIN_CAP) { atomicAdd(&bar[XB_TMO], 1u); break; } }
    }
    nloc = mine > 0u ? mine : 1u; nx = cnt > 0u ? cnt : 1u;
}

__device__ __forceinline__ void xcd_barrier(const XcdBarrier& b) {
    asm volatile("s_waitcnt vmcnt(0)" ::: "memory");
    __syncthreads();
    if (threadIdx.x == 0) {
        unsigned* bar = b.bar;
        __builtin_amdgcn_s_waitcnt(0);
        unsigned nloc = b.st[0], nx = b.st[1];
        if (nloc == 0u) { xcd_barrier_complete(bar, b.x, nloc, nx); b.st[0] = nloc; b.st[1] = nx; }
        const unsigned old = xb_add(&bar[XB_XSUB(b.x)], 1u);
        const unsigned gen = old / nloc;
        if (old + 1u == (gen + 1u) * nloc) {
            __builtin_amdgcn_fence(__ATOMIC_RELEASE, "agent");
            asm volatile("s_waitcnt vmcnt(0)" ::: "memory");
            const unsigned og = xb_add(&bar[XB_TOP], 1u);
            const unsigned tg = og / nx;
            if (og + 1u == (tg + 1u) * nx) xb_add(&bar[XB_TOPGEN], 1u);
            else XB_SPIN(xb_ld(&bar[XB_TOPGEN]) == tg, bar);
            __builtin_amdgcn_fence(__ATOMIC_ACQUIRE, "agent");
            xb_add(&bar[XB_XGEN(b.x)], 1u);
            asm volatile("s_waitcnt vmcnt(0)" ::: "memory");
        } else {
            XB_SPIN(xb_ld(&bar[XB_XGEN(b.x)]) == gen, bar);
            __builtin_amdgcn_fence(__ATOMIC_ACQUIRE, "agent");
            asm volatile("s_waitcnt vmcnt(0)" ::: "memory");
        }
    }
    __syncthreads();
}
typedef unsigned short bf16_t;
typedef float f32x4 __attribute__((ext_vector_type(4)));
typedef unsigned u32x4 __attribute__((ext_vector_type(4)));
typedef unsigned u32x2 __attribute__((ext_vector_type(2)));
using att::bf16x8; using att::s16x4; using att::f32x16; using att::crow; using att::cvtpk;

constexpr int DM = 2048, SEQ = 8192, CTXL = 256, MROWS = SEQ + CTXL  , NPROJ = 4608, NPROJ_PAD = 4864, INPROJ = 4624, DFF = 5632, NUP = 2 * DFF;
constexpr int OFF_AQ = 0, OFF_AK = 1024, OFF_AV = 1280, OFF_MQ = 1536, OFF_MK = 2048, OFF_MV = 2560, OFF_MO = 3584;
constexpr float EPS = 1e-6f;
constexpr int NSTEP = 132, SROWS = 257; constexpr size_t ST_BLK = (size_t)SROWS * 128;
constexpr size_t MiB = 1u << 20;
constexpr size_t WS_MODX = 0, WS_MODC = 64 * 1024, WS_BL = 128 * 1024, WS_G = 256 * 1024, WS_BAR = 1 * MiB, BAR_BYTES = 65536, WS_CNT1 = 1 * MiB + 16384, WS_CNT2 = 1 * MiB + 32768, WS_SLOT1 = 1 * MiB + 256 * 1024, WS_SLOT2 = 1 * MiB + 512 * 1024;
constexpr size_t WS_WDOWN = 2 * MiB, WS_WIN = 24 * MiB, WS_WOUT = 43 * MiB, WS_WUP = 51 * MiB, WS_H = 95 * MiB, WS_MIX = 128 * MiB, WS_ACT = 24 * MiB;
constexpr size_t WS_P = 160 * MiB, WS_ST = 235 * MiB, WS_U = 160 * MiB, WS_TILE = 256 * MiB, WS_END = 368 * MiB;
constexpr int LDS_BYTES = 131072 + 1024;
constexpr int NPHASE = 12;
#ifndef FLATBAR
#define FLATBAR 0
#endif
#ifndef XTRA_BAR
#define XTRA_BAR 0
#endif
#ifndef REP_ATT
#define REP_ATT 0
#endif
#ifndef PROBE_B
#define PROBE_B 0
#endif
#ifndef PROBE_10
#define PROBE_10 0
#endif
#ifndef FUSE_NORM
#define FUSE_NORM 1
#endif
#ifndef REP_C
#define REP_C 0
#define REP_A 0
#endif
#ifndef REPMASK
#define REPMASK 0
#endif
#ifndef TAILS
#define TAILS 1
#endif

__device__ __forceinline__ float bf2f(unsigned v) { return __uint_as_float(v << 16); }
typedef float f32x2_t __attribute__((ext_vector_type(2))); typedef __bf16 bf16x2_t __attribute__((ext_vector_type(2)));
__device__ __forceinline__ unsigned pkbf(float lo, float hi) { const f32x2_t v = {lo, hi}; const bf16x2_t b = __builtin_convertvector(v, bf16x2_t); return __builtin_bit_cast(unsigned, b); }
__device__ __forceinline__ float wave_sum(float v) {
#pragma unroll
    for (int o = 1; o < 64; o <<= 1) v += __shfl_xor(v, o);
    return v;
}
__device__ __forceinline__ float log_sigmoid(float x) { return fminf(x, 0.f) - log1pf(__expf(-fabsf(x))); }

template <bool UPPERM = false, bool NTST = false> __device__ __forceinline__ void p0_transpose_item(const float* W, int K, int N, bf16_t* WT, LAS float* scr, int item, int lane) {
    const int nblk = (N + 31) / 32, kb = item / nblk, nb = item % nblk, k0 = 64 * kb, n0 = 32 * nb;
    const int nd0 = UPPERM ? (n0 < 5632 ? (n0 >> 7) * 256 + (n0 & 127) : ((n0 - 5632) >> 7) * 256 + 128 + ((n0 - 5632) & 127)) : n0;
    const int c4 = (lane & 7) * 4, kr = lane >> 3; const bool okc = n0 + c4 < N;
    f32x4 v[8];
#pragma unroll
    for (int i = 0; i < 8; ++i) v[i] = okc ? __builtin_nontemporal_load((const f32x4*)(W + (size_t)(k0 + kr + 8 * i) * N + n0 + c4)) : (f32x4){0.f, 0.f, 0.f, 0.f};
#pragma unroll
    for (int i = 0; i < 8; ++i) { LAS float* d = scr + (kr + 8 * i) * 33 + c4; d[0] = v[i].x; d[1] = v[i].y; d[2] = v[i].z; d[3] = v[i].w; }
    asm volatile("s_waitcnt lgkmcnt(0)" ::: "memory");
    const int c = lane & 7;
#pragma unroll
    for (int j = 0; j < 4; ++j) { const int n = (lane >> 3) + 8 * j; const LAS float* s = scr + (8 * c) * 33 + n;
        u32x4 o; o.x = pkbf(s[0 * 33], s[1 * 33]); o.y = pkbf(s[2 * 33], s[3 * 33]); o.z = pkbf(s[4 * 33], s[5 * 33]); o.w = pkbf(s[6 * 33], s[7 * 33]);
        if (NTST) __builtin_nontemporal_store(o, (u32x4*)(WT + (size_t)(nd0 + n) * K + k0 + 8 * c)); else *(u32x4*)(WT + (size_t)(nd0 + n) * K + k0 + 8 * c) = o; }
    asm volatile("s_waitcnt lgkmcnt(0)" ::: "memory");
}
__device__ __forceinline__ void p0_gemv_item(const float* wmod, const float* bmod, float* modx, float* modc, char* lds, int item) {
    const int tid = ltid(); const float* sx = (const float*)lds; const float* sc = sx + 2048; float* red = (float*)(lds + 16384);
    const int n0 = item * 64, c4 = (tid & 15) * 4, kr = tid >> 4;
    f32x4 ax = {0.f, 0.f, 0.f, 0.f}, ac = {0.f, 0.f, 0.f, 0.f};
#pragma unroll 8
    for (int j = 0; j < 64; ++j) { const int k = kr + 32 * j; const f32x4 w = __builtin_nontemporal_load((const f32x4*)(wmod + (size_t)k * 12288 + n0 + c4)); ax += w * sx[k]; ac += w * sc[k]; }
    *(f32x4*)(red + (kr * 16 + (tid & 15)) * 8) = ax; *(f32x4*)(red + (kr * 16 + (tid & 15)) * 8 + 4) = ac;
    __syncthreads();
    if (tid < 128) { const int col = tid & 63, which = tid >> 6; float s = 0.f;
        for (int k2 = 0; k2 < 32; ++k2) s += red[(k2 * 16 + (col >> 2)) * 8 + which * 4 + (col & 3)];
        s += bmod[n0 + col]; (which ? modc : modx)[n0 + col] = s; }
    __syncthreads();
}
__device__ __forceinline__ void norm_mod_row(const float* xrow, const float* g, const float* sh, const float* sc, bf16_t* orow, int lane) {
    const f32x4* xr = (const f32x4*)xrow + lane; f32x4 v[8]; float s = 0.f;
#pragma unroll
    for (int j = 0; j < 8; ++j) { v[j] = __builtin_nontemporal_load(xr + 64 * j); s += (v[j].x * v[j].x + v[j].y * v[j].y) + (v[j].z * v[j].z + v[j].w * v[j].w); }
    const float rstd = rsqrtf(wave_sum(s) * (1.f / 2048.f) + EPS);
    u32x2* o8 = (u32x2*)orow + lane;
#pragma unroll
    for (int j = 0; j < 8; ++j) { const f32x4 gg = ((const f32x4*)g)[lane + 64 * j], s1 = ((const f32x4*)sc)[lane + 64 * j], s0 = ((const f32x4*)sh)[lane + 64 * j];
        const f32x4 y = (v[j] * rstd * gg) * (s1 + 1.0f) + s0; u32x2 w; w.x = pkbf(y.x, y.y); w.y = pkbf(y.z, y.w); o8[64 * j] = w; }
}
__device__ __forceinline__ void final_norm_row(float* xrow, const float* g, int lane) {
    f32x4* xr = (f32x4*)xrow + lane; f32x4 v[8]; float s = 0.f;
#pragma unroll
    for (int j = 0; j < 8; ++j) { v[j] = xr[64 * j]; s += (v[j].x * v[j].x + v[j].y * v[j].y) + (v[j].z * v[j].z + v[j].w * v[j].w); }
    const float rstd = rsqrtf(wave_sum(s) * (1.f / 2048.f) + EPS);
#pragma unroll
    for (int j = 0; j < 8; ++j) { const f32x4 gg = ((const f32x4*)g)[lane + 64 * j]; xr[64 * j] = v[j] * rstd * gg; }
}
constexpr int QK_TASKS = SEQ * 10 + CTXL * 2;
__device__ __forceinline__ void qk_prep_task(bf16_t* P, int t, const float* qn, const float* kn, int lane) {
    int row, hh; if (t < SEQ * 10) { row = t / 10; hh = t - row * 10; } else { const int t2 = t - SEQ * 10; row = SEQ + (t2 >> 1); hh = 8 + (t2 & 1); }
    const bool is_x = row < SEQ; const int sl = lane & 7, half = sl >> 2, i0 = (sl & 3) * 8, e1 = 64 * half + i0;
    bf16_t* hp = P + (size_t)row * NPROJ + (hh < 8 ? OFF_AQ + hh * 128 : OFF_AK + (hh - 8) * 128) + e1;
    const u32x4 ra = *(const u32x4*)hp, rb = *(const u32x4*)(hp + 32);
    const float* gn = (hh < 8 ? qn : kn) + e1;
    const f32x4 ga0 = *(const f32x4*)gn, ga1 = *(const f32x4*)(gn + 4), gb0 = *(const f32x4*)(gn + 32), gb1 = *(const f32x4*)(gn + 36);
    float x1[8], x2[8]; float ss = 0.f;
#pragma unroll
    for (int j = 0; j < 4; ++j) { x1[2 * j] = __uint_as_float(ra[j] << 16); x1[2 * j + 1] = __uint_as_float(ra[j] & 0xffff0000u); x2[2 * j] = __uint_as_float(rb[j] << 16); x2[2 * j + 1] = __uint_as_float(rb[j] & 0xffff0000u); }
#pragma unroll
    for (int j = 0; j < 8; ++j) ss += x1[j] * x1[j] + x2[j] * x2[j];
    ss += __shfl_xor(ss, 1); ss += __shfl_xor(ss, 2); ss += __shfl_xor(ss, 4);
    const float rstd = rsqrtf(ss * (1.f / 128.f) + EPS);
    const float pos = (float)(half == 0 ? (row >> 6) : (row & 63));
    float o1[8], o2[8];
#pragma unroll
    for (int j = 0; j < 8; ++j) {
        float cs = 1.f, sn = 0.f;
        if (is_x) { const float invf = exp2f(-(float)(i0 + j) * (13.287712379549449f / 32.0f));
            const float rev = pos * invf * 0.15915494309189535f; cs = __builtin_amdgcn_cosf(rev); sn = __builtin_amdgcn_sinf(rev); }
        const float y1 = x1[j] * rstd * (j < 4 ? ga0[j & 3] : ga1[j & 3]), y2 = x2[j] * rstd * (j < 4 ? gb0[j & 3] : gb1[j & 3]);
        o1[j] = y1 * cs - y2 * sn; o2[j] = y2 * cs + y1 * sn; }
    u32x4 wa, wb;
#pragma unroll
    for (int j = 0; j < 4; ++j) { wa[j] = pkbf(o1[2 * j], o1[2 * j + 1]); wb[j] = pkbf(o2[2 * j], o2[2 * j + 1]); }
    *(u32x4*)hp = wa; *(u32x4*)(hp + 32) = wb;
}
__device__ __forceinline__ void gate_scan(const float* G, const float* b_i, const float* b_f, int row0, int h, int dir, int lane, float& b, float& ip, float& bL) {
    const float* g = G + (size_t)(row0 + lane) * 16 + dir * 8;
    ip = g[h] + b_i[dir * 4 + h];
    b = log_sigmoid(g[4 + h] + b_f[dir * 4 + h]);
    if (dir == 0) {
#pragma unroll
        for (int o = 1; o < 64; o <<= 1) { const float v = __shfl_up(b, o); if (lane >= o) b += v; }
        bL = __shfl(b, 63);
    } else {
#pragma unroll
        for (int o = 1; o < 64; o <<= 1) { const float v = __shfl_down(b, o); if (lane + o < 64) b += v; }
        bL = __shfl(b, 0);
    }
}
__device__ __forceinline__ s16x4 vtr(const LAS char* p) { typedef short v4i16_t __attribute__((ext_vector_type(4)));
    return __builtin_bit_cast(s16x4, __builtin_amdgcn_ds_read_tr16_b64_v4i16((LAS v4i16_t*)p)); }
__device__ __forceinline__ bf16x8 trfrag(const LAS char* base, int off) { const s16x4 l = vtr(base + off), h = vtr(base + off + 2048);
    return (bf16x8){l[0], l[1], l[2], l[3], h[0], h[1], h[2], h[3]}; }
__device__ __forceinline__ bf16x8 scale8(bf16x8 k, float w) { const u32x4 u = __builtin_bit_cast(u32x4, k); u32x4 o;
#pragma unroll
    for (int j = 0; j < 4; ++j) o[j] = pkbf(__uint_as_float(u[j] << 16) * w, __uint_as_float(u[j] & 0xffff0000u) * w);
    return __builtin_bit_cast(bf16x8, o); }
__device__ __forceinline__ bf16x8 pack8(f32x4 a, f32x4 b) { u32x4 o; o.x = pkbf(a.x, a.y); o.y = pkbf(a.z, a.w); o.z = pkbf(b.x, b.y); o.w = pkbf(b.z, b.w); return __builtin_bit_cast(bf16x8, o); }
__device__ __forceinline__ int step_of(int dir, int c) { return dir == 0 ? (c < 128 ? c + 4 : c - 128) : 131 - c; }

__device__ __forceinline__ void mlstm_passA(char* lds, const bf16_t* P, const float* G, const float* b_i, const float* b_f, bf16_t* ST, float* BL, int item) {
    const int tid = ltid(), wid = tid >> 6, lane = tid & 63, r32 = lane & 31, hi = lane >> 5;
    const int c = item >> 2, h = item & 3, row0 = c * 64;
    float* wts = (float*)(lds + 65536);
    if (wid < 2) { float b, ip, bL; gate_scan(G, b_i, b_f, row0, h, wid, lane, b, ip, bL); wts[wid * 64 + lane] = __expf(bL - b + ip);
        if (lane == 0) BL[(wid * 4 + h) * NSTEP + step_of(wid, c)] = bL; }
    __syncthreads();
#pragma unroll
    for (int i = 0; i < 4; ++i) { const int p = tid + 512 * i, r = p >> 5, cc = (p & 31) * 8;
        const bf16x8 v = *(const bf16x8*)(P + (size_t)(row0 + r) * NPROJ + OFF_MV + h * 256 + cc);
        *(bf16x8*)(lds + (cc >> 7) * 16384 + att::v_st(r, cc & 127)) = v; }
#pragma unroll
    for (int i = 0; i < 2; ++i) { const int p = tid + 512 * i, r = p >> 4, cc = (p & 15) * 8;
        const bf16x8 k = *(const bf16x8*)(P + (size_t)(row0 + r) * NPROJ + OFF_MK + h * 128 + cc);
        *(bf16x8*)(lds + 32768 + att::v_st(r, cc)) = scale8(k, wts[r]); *(bf16x8*)(lds + 49152 + att::v_st(r, cc)) = scale8(k, wts[64 + r]); }
    __syncthreads();
    const int dir = wid >> 2, cb = wid & 3;
    const LAS char* L = (const LAS char*)lds + att::v_rd_base(lane);
    const LAS char* La = L + (cb >> 1) * 16384 + ((2 * cb) & 3) * 512;
    const LAS char* Lb = L + 32768 + dir * 16384;
    bf16_t* base = ST + ((size_t)(dir * 4 + h) * NSTEP + step_of(dir, c)) * ST_BLK;
#pragma nounroll
    for (int a = 0; a < 2; ++a) {
        f32x16 acc[4];
#pragma unroll
        for (int b = 0; b < 4; ++b) acc[b] = f32x16{};
        const LAS char* Laa = La + a * 512;
#pragma unroll
        for (int ks = 0; ks < 4; ++ks) {
            const bf16x8 A = trfrag(Laa, ks * 4096);
#pragma unroll
            for (int b = 0; b < 4; ++b) acc[b] = __builtin_amdgcn_mfma_f32_32x32x16_bf16(A, trfrag(Lb, b * 512 + ks * 4096), acc[b], 0, 0, 0);
        }
#pragma unroll
        for (int b = 0; b < 4; ++b)
#pragma unroll
            for (int r = 0; r < 16; ++r) base[(size_t)(64 * cb + 32 * a + crow(r, hi)) * 128 + 32 * b + r32] = (bf16_t)(pkbf(acc[b][r], acc[b][r]) & 0xffffu);
    }
    if (cb == 0) {
        f32x16 an[4];
#pragma unroll
        for (int b = 0; b < 4; ++b) an[b] = f32x16{};
        const short one = (r32 == 0) ? (short)0x3F80 : (short)0; const bf16x8 A1 = {one, one, one, one, one, one, one, one};
#pragma unroll
        for (int ks = 0; ks < 4; ++ks)
#pragma unroll
            for (int b = 0; b < 4; ++b) an[b] = __builtin_amdgcn_mfma_f32_32x32x16_bf16(A1, trfrag(Lb, b * 512 + ks * 4096), an[b], 0, 0, 0);
        if (hi == 0) {
#pragma unroll
            for (int b = 0; b < 4; ++b) base[(size_t)256 * 128 + 32 * b + r32] = (bf16_t)(pkbf(an[b][0], an[b][0]) & 0xffffu);
        }
    }
    __syncthreads();
}
__device__ __forceinline__ void mlstm_passB(bf16_t* ST, const float* BL, bf16_t* DST = nullptr, int ndh = 8) {
    constexpr int PER = (int)(ST_BLK / 2); constexpr size_t SB = ST_BLK / 2;
    const int nthr = gridDim.x * 512;
    for (int e = blockIdx.x * 512 + ltid(); e < ndh * PER; e += nthr) {
        const int dh = e / PER, idx = e - dh * PER;
        unsigned* p = (unsigned*)(ST + (size_t)dh * NSTEP * ST_BLK) + idx; const float* bl = BL + dh * NSTEP;
        unsigned* q = DST ? (unsigned*)(DST + (size_t)dh * NSTEP * ST_BLK) + idx : p;
        float c0 = 0.f, c1 = 0.f;
        unsigned cur[12], nxt[12];
#pragma unroll
        for (int j = 0; j < 12; ++j) cur[j] = __builtin_nontemporal_load(p + (size_t)j * SB);
        for (int s = 0; s < NSTEP; s += 12) {
#pragma unroll
            for (int j = 0; j < 12; ++j) nxt[j] = (s + 12 + j < NSTEP) ? __builtin_nontemporal_load(p + (size_t)(s + 12 + j) * SB) : 0u;
#pragma unroll
            for (int j = 0; j < 12; ++j) { const float d = __expf(bl[s + j]);
                q[(size_t)(s + j) * SB] = pkbf(c0, c1);
                c0 = c0 * d + __uint_as_float(cur[j] << 16); c1 = c1 * d + __uint_as_float(cur[j] & 0xffff0000u); }
#pragma unroll
            for (int j = 0; j < 12; ++j) cur[j] = nxt[j];
        }
    }
}
__device__ __forceinline__ void mlstm_passC(char* lds, const bf16_t* P, const float* G, const float* b_i, const float* b_f, const bf16_t* ST, const float* mnorm, bf16_t* MIX, int item) {
    const int tid = ltid(), wid = tid >> 6, lane = tid & 63, r32 = lane & 31, hi = lane >> 5;
    const int c = item >> 2, h = item & 3, row0 = c * 64;
    float* bq = (float*)(lds + 49152); float* ak = bq + 128; float* eq = ak + 128; float* ssq = eq + 128;
    if (wid < 2) { float b, ip, bL; gate_scan(G, b_i, b_f, row0, h, wid, lane, b, ip, bL); bq[wid * 64 + lane] = b; ak[wid * 64 + lane] = b - ip; eq[wid * 64 + lane] = __expf(b); }
    { const int sr = tid >> 4, sc = (tid & 15) * 8;
#pragma unroll
      for (int i = 0; i < 2; ++i) { const int r = sr + 32 * i; const bf16x8 k = *(const bf16x8*)(P + (size_t)(row0 + r) * NPROJ + OFF_MK + h * 128 + sc);
          *(bf16x8*)(lds + KSWZ(r, sc * 2)) = k; } }
#pragma unroll
    for (int i = 0; i < 4; ++i) { const int p = tid + 512 * i, r = p >> 5, cc = (p & 31) * 8;
        const bf16x8 v = *(const bf16x8*)(P + (size_t)(row0 + r) * NPROJ + OFF_MV + h * 256 + cc);
        *(bf16x8*)(lds + 16384 + (cc >> 7) * 16384 + att::v_st(r, cc & 127)) = v; }
    const int rb = wid >> 2, cb = wid & 3, q = 32 * rb + r32;
    bf16x8 qr[8];
    { const bf16_t* Qw = P + (size_t)(row0 + q) * NPROJ + OFF_MQ + h * 128 + hi * 8;
#pragma unroll
      for (int d0 = 0; d0 < 8; ++d0) qr[d0] = *(const bf16x8*)(Qw + d0 * 16); }
    bf16x8 fr[3][8];
#define LOAD_FR(d) do { const bf16_t* base_ = ST + ((size_t)((d) * 4 + h) * NSTEP + step_of((d), c)) * ST_BLK; \
        _Pragma("unroll") for (int t = 0; t < 3; ++t) { const bf16_t* src = base_ + (size_t)(t < 2 ? 64 * cb + 32 * t + r32 : 256) * 128 + 8 * hi; \
            _Pragma("unroll") for (int ks = 0; ks < 8; ++ks) { fr[t][ks] = (bf16x8){0, 0, 0, 0, 0, 0, 0, 0}; if (t < 2 || r32 == 0) fr[t][ks] = *(const bf16x8*)(src + 16 * ks); } } } while (0)
    LOAD_FR(0);
    __syncthreads();
    f32x16 acc[2][3];
#pragma unroll
    for (int d = 0; d < 2; ++d)
#pragma unroll
        for (int t = 0; t < 3; ++t) acc[d][t] = f32x16{};
#pragma unroll
    for (int d = 0; d < 2; ++d) {
        if (d == 1) LOAD_FR(1);
#pragma unroll
        for (int t = 0; t < 3; ++t)
#pragma unroll
            for (int ks = 0; ks < 8; ++ks) acc[d][t] = __builtin_amdgcn_mfma_f32_32x32x16_bf16(qr[ks], fr[t][ks], acc[d][t], 0, 0, 0);
#pragma unroll
        for (int r = 0; r < 16; ++r) { const float e = eq[d * 64 + 32 * rb + crow(r, hi)];
#pragma unroll
            for (int t = 0; t < 3; ++t) acc[d][t][r] *= e; }
    }
#undef LOAD_FR
    float ogv[2][16], mnv[2];
#pragma unroll
    for (int t = 0; t < 2; ++t) { const int col = 64 * cb + 32 * t + r32; mnv[t] = mnorm[h * 256 + col];
#pragma unroll
        for (int r = 0; r < 16; ++r) ogv[t][r] = bf2f(P[(size_t)(row0 + 32 * rb + crow(r, hi)) * NPROJ + OFF_MO + h * 256 + col]); }
    f32x16 p0, p1; att::qkt(p0, p1, (const bf16_t*)lds, qr, r32, hi);
    const LAS char* Lv = (const LAS char*)lds + 16384 + att::v_rd_base(lane) + (cb >> 1) * 16384 + ((2 * cb) & 3) * 512;
    const short one = (r32 == 0) ? (short)0x3F80 : (short)0; const bf16x8 B1 = {one, one, one, one, one, one, one, one};
#pragma unroll
    for (int d = 0; d < 2; ++d) {
        const float bqv = bq[d * 64 + q]; f32x16 e0, e1;
#pragma unroll
        for (int r = 0; r < 16; ++r) { const int k0 = crow(r, hi), k1 = 32 + k0;
            const bool v0 = d == 0 ? (k0 <= q) : (k0 >= q), v1 = d == 0 ? (k1 <= q) : (k1 >= q);
            const float x0 = __expf(bqv - ak[d * 64 + k0]), x1 = __expf(bqv - ak[d * 64 + k1]);
            e0[r] = v0 ? p0[r] * x0 : 0.f; e1[r] = v1 ? p1[r] * x1 : 0.f; }
        bf16x8 pa0, pa1, pa2, pa3; PK4(e0, 0, pa0); PK4(e0, 8, pa1); PK4(e1, 0, pa2); PK4(e1, 8, pa3);
#pragma unroll
        for (int t = 0; t < 2; ++t) {
            acc[d][t] = __builtin_amdgcn_mfma_f32_32x32x16_bf16(pa0, trfrag(Lv, t * 512 + 0 * 4096), acc[d][t], 0, 0, 0);
            acc[d][t] = __builtin_amdgcn_mfma_f32_32x32x16_bf16(pa1, trfrag(Lv, t * 512 + 1 * 4096), acc[d][t], 0, 0, 0);
            acc[d][t] = __builtin_amdgcn_mfma_f32_32x32x16_bf16(pa2, trfrag(Lv, t * 512 + 2 * 4096), acc[d][t], 0, 0, 0);
            acc[d][t] = __builtin_amdgcn_mfma_f32_32x32x16_bf16(pa3, trfrag(Lv, t * 512 + 3 * 4096), acc[d][t], 0, 0, 0);
        }
        acc[d][2] = __builtin_amdgcn_mfma_f32_32x32x16_bf16(pa0, B1, acc[d][2], 0, 0, 0);
        acc[d][2] = __builtin_amdgcn_mfma_f32_32x32x16_bf16(pa1, B1, acc[d][2], 0, 0, 0);
        acc[d][2] = __builtin_amdgcn_mfma_f32_32x32x16_bf16(pa2, B1, acc[d][2], 0, 0, 0);
        acc[d][2] = __builtin_amdgcn_mfma_f32_32x32x16_bf16(pa3, B1, acc[d][2], 0, 0, 0);
    }
    f32x16 hv[2];
#pragma unroll
    for (int r = 0; r < 16; ++r) {
        const int f0 = __builtin_amdgcn_readlane(__float_as_int(acc[0][2][r]), 0), f1 = __builtin_amdgcn_readlane(__float_as_int(acc[0][2][r]), 32);
        const int g0 = __builtin_amdgcn_readlane(__float_as_int(acc[1][2][r]), 0), g1 = __builtin_amdgcn_readlane(__float_as_int(acc[1][2][r]), 32);
        const float df = __int_as_float(hi ? f1 : f0), db = __int_as_float(hi ? g1 : g0);
        const float invf = __builtin_amdgcn_rcpf(fmaxf(fabsf(df), 1.0f)), invb = __builtin_amdgcn_rcpf(fmaxf(fabsf(db), 1.0f));
        hv[0][r] = acc[0][0][r] * invf + acc[1][0][r] * invb; hv[1][r] = acc[0][1][r] * invf + acc[1][1][r] * invb;
    }
    { float s16[16];
#pragma unroll
      for (int r = 0; r < 16; ++r) s16[r] = hv[0][r] * hv[0][r] + hv[1][r] * hv[1][r];
      float s8[8], s4[4], s2[2], s1;
#pragma unroll
      for (int r = 0; r < 8; ++r) { const float keep = (lane & 16) ? s16[8 + r] : s16[r], give = (lane & 16) ? s16[r] : s16[8 + r]; s8[r] = keep + __shfl_xor(give, 16); }
#pragma unroll
      for (int r = 0; r < 4; ++r) { const float keep = (lane & 8) ? s8[4 + r] : s8[r], give = (lane & 8) ? s8[r] : s8[4 + r]; s4[r] = keep + __shfl_xor(give, 8); }
#pragma unroll
      for (int r = 0; r < 2; ++r) { const float keep = (lane & 4) ? s4[2 + r] : s4[r], give = (lane & 4) ? s4[r] : s4[2 + r]; s2[r] = keep + __shfl_xor(give, 4); }
      { const float keep = (lane & 2) ? s2[1] : s2[0], give = (lane & 2) ? s2[0] : s2[1]; s1 = keep + __shfl_xor(give, 2); }
      s1 += __shfl_xor(s1, 1);
      const int rr = ((lane >> 4) & 1) * 8 + ((lane >> 3) & 1) * 4 + ((lane >> 2) & 1) * 2 + ((lane >> 1) & 1);
      if ((lane & 1) == 0) ssq[cb * 64 + 32 * rb + crow(rr, hi)] = s1; }
    __syncthreads();
#pragma unroll
    for (int r = 0; r < 16; ++r) { const int row = 32 * rb + crow(r, hi); const float rstd = rsqrtf(((ssq[row] + ssq[64 + row]) + (ssq[128 + row] + ssq[192 + row])) * (1.f / 256.f) + EPS);
#pragma unroll
        for (int t = 0; t < 2; ++t) { const int col = 64 * cb + 32 * t + r32;
            const float val = hv[t][r] * rstd * mnv[t] * ogv[t][r];
            MIX[(size_t)(row0 + row) * DM + 1024 + h * 256 + col] = (bf16_t)(pkbf(val, val) & 0xffffu); } }
    __syncthreads();
}
__device__ __forceinline__ void conv_gate_item(const bf16_t* U, const float* cw, const float* cbias, bf16_t* ACT, int item) {
    const int cgp = item % 704, rr = item / 704, j0 = cgp * 8, t0 = rr * 16;
    float w0g[8], w1g[8], w2g[8], bg[8], w0v[8], w1v[8], w2v[8], bv[8];
#pragma unroll
    for (int j = 0; j < 8; ++j) { w0g[j] = cw[j0 + j]; w1g[j] = cw[NUP + j0 + j]; w2g[j] = cw[2 * NUP + j0 + j]; bg[j] = cbias[j0 + j];
        w0v[j] = cw[DFF + j0 + j]; w1v[j] = cw[NUP + DFF + j0 + j]; w2v[j] = cw[2 * NUP + DFF + j0 + j]; bv[j] = cbias[DFF + j0 + j]; }
    const u32x4 z = {0u, 0u, 0u, 0u};
    u32x4 pg = z, pv = z;
    if (t0 > 0) { pg = __builtin_nontemporal_load((const u32x4*)(U + (size_t)(t0 - 1) * NUP + j0)); pv = __builtin_nontemporal_load((const u32x4*)(U + (size_t)(t0 - 1) * NUP + DFF + j0)); }
    u32x4 cg_ = __builtin_nontemporal_load((const u32x4*)(U + (size_t)t0 * NUP + j0)), cv = __builtin_nontemporal_load((const u32x4*)(U + (size_t)t0 * NUP + DFF + j0));
    for (int t = t0; t < t0 + 16; ++t) {
        u32x4 ng = z, nv = z;
        if (t + 1 < SEQ) { ng = __builtin_nontemporal_load((const u32x4*)(U + (size_t)(t + 1) * NUP + j0)); nv = __builtin_nontemporal_load((const u32x4*)(U + (size_t)(t + 1) * NUP + DFF + j0)); }
        u32x4 o;
#pragma unroll
        for (int jj = 0; jj < 4; ++jj) {
            float r2[2];
#pragma unroll
            for (int e = 0; e < 2; ++e) { const int j = 2 * jj + e;
                const float a = e ? __uint_as_float(pg[jj] & 0xffff0000u) : __uint_as_float(pg[jj] << 16);
                const float b = e ? __uint_as_float(cg_[jj] & 0xffff0000u) : __uint_as_float(cg_[jj] << 16);
                const float d = e ? __uint_as_float(ng[jj] & 0xffff0000u) : __uint_as_float(ng[jj] << 16);
                const float av = e ? __uint_as_float(pv[jj] & 0xffff0000u) : __uint_as_float(pv[jj] << 16);
                const float bvv = e ? __uint_as_float(cv[jj] & 0xffff0000u) : __uint_as_float(cv[jj] << 16);
                const float dv = e ? __uint_as_float(nv[jj] & 0xffff0000u) : __uint_as_float(nv[jj] << 16);
                const float gc = w0g[j] * a + w1g[j] * b + w2g[j] * d + bg[j];
                const float vc = w0v[j] * av + w1v[j] * bvv + w2v[j] * dv + bv[j];
                r2[e] = gc * __builtin_amdgcn_rcpf(1.0f + __builtin_amdgcn_exp2f(-1.4426950408889634f * gc)) * vc; }
            o[jj] = pkbf(r2[0], r2[1]); }
        *(u32x4*)(ACT + (size_t)t * DFF + j0) = o;
        pg = cg_; pv = cv; cg_ = ng; cv = nv;
    }
}

__device__ __forceinline__ void flat_barrier(unsigned* cnt, unsigned target) {
    asm volatile("s_waitcnt vmcnt(0)" ::: "memory");
    __syncthreads();
    if (threadIdx.x == 0) {
        __builtin_amdgcn_fence(__ATOMIC_RELEASE, "agent");
        asm volatile("s_waitcnt vmcnt(0)" ::: "memory");
        __hip_atomic_fetch_add(cnt, 1u, __ATOMIC_RELAXED, __HIP_MEMORY_SCOPE_AGENT);
        unsigned sp = 0;
        while (__hip_atomic_load(cnt, __ATOMIC_RELAXED, __HIP_MEMORY_SCOPE_AGENT) < target) { __builtin_amdgcn_s_sleep(1); if (++sp > (1u << 22)) break; }
        __builtin_amdgcn_fence(__ATOMIC_ACQUIRE, "agent");
        asm volatile("s_waitcnt vmcnt(0)" ::: "memory");
    }
    __syncthreads();
}
struct Args { const float* in[20]; float* out; unsigned char* ws; int ph_lo, ph_hi, coop, pad; };

__global__ void __launch_bounds__(512) fwd_kernel(Args a) {
    extern __shared__ __attribute__((aligned(16))) unsigned char lds[];
    const int G_ = gridDim.x, bid = blockIdx.x; const int NGW = G_ * 8;
#define TIDS const int tid = ltid(), lane = tid & 63, wave = __builtin_amdgcn_readfirstlane(tid >> 6), gw = bid * 8 + wave; (void)tid; (void)lane; (void)gw
#define x_in (a.in[0])
#define cvec (a.in[1])
#define ctx (a.in[2])
#define cctx (a.in[3])
#define wmod (a.in[4])
#define bmod (a.in[5])
#define norm1 (a.in[6])
#define w_in (a.in[7])
#define qn (a.in[8])
#define kn (a.in[9])
#define b_ig (a.in[10])
#define b_fg (a.in[11])
#define mnorm (a.in[12])
#define w_out (a.in[13])
#define norm2 (a.in[14])
#define w_up (a.in[15])
#define convw (a.in[16])
#define convb (a.in[17])
#define w_down (a.in[18])
#define normf (a.in[19])
#define outp (a.out)
#define modx ((float*)(a.ws + WS_MODX))
#define modc ((float*)(a.ws + WS_MODC))
#define BL ((float*)(a.ws + WS_BL))
#define Gt ((float*)(a.ws + WS_G))
#define Wdown_t ((bf16_t*)(a.ws + WS_WDOWN))
#define Win_t ((bf16_t*)(a.ws + WS_WIN))
#define Wout_t ((bf16_t*)(a.ws + WS_WOUT))
#define Wup_t ((bf16_t*)(a.ws + WS_WUP))
#define H ((bf16_t*)(a.ws + WS_H))
#define MIX ((bf16_t*)(a.ws + WS_MIX))
#define ACT ((bf16_t*)(a.ws + WS_ACT))
#define P ((bf16_t*)(a.ws + WS_P))
#define ST ((bf16_t*)(a.ws + WS_ST))
#define U ((bf16_t*)(a.ws + WS_U))
    const int lo = a.ph_lo, hi_ = a.ph_hi;
#ifndef PH_MASK
#define PH_MASK 0xfff
#endif
#define IN(k) (((PH_MASK >> (k)) & 1) && lo <= (k) && (k) < hi_)
#if FLATBAR
    unsigned bar_epoch = 0;
#define SEAM(k) do { if (IN(k) && IN((k) + 1)) { bar_epoch += gridDim.x; flat_barrier((unsigned*)(a.ws + WS_BAR) + 64, bar_epoch); } } while (0)
#else
#define SEAM(k) do { if (IN(k) && IN((k) + 1)) xcd_barrier(bar); } while (0)
#endif
    if (threadIdx.x < 32) ((volatile LAS unsigned*)((LAS unsigned char*)lds + 131072))[threadIdx.x] = 0u;
    __syncthreads();
    XcdBarrier bar; bar.bar = (unsigned*)(a.ws + WS_BAR); bar.x = 0; bar.st = nullptr;
    if (a.coop) { bar = xcd_barrier_post((unsigned*)(a.ws + WS_BAR), (volatile LAS unsigned*)((LAS unsigned char*)lds + 131072)); cg::this_grid().sync(); }

    for (int rep_ = 0; rep_ < (IN(0) ? 1 + ((REPMASK >> 0) & 1) : 0); ++rep_) { TIDS;
        float* sx = (float*)lds;
        for (int i = tid; i < 2048; i += 512) { const float v = cvec[i]; sx[i] = v / (1.0f + __expf(-v)); const float w = cctx[i]; sx[2048 + i] = w / (1.0f + __expf(-w)); }
        __syncthreads();
        for (int it = bid; it < 192; it += G_) p0_gemv_item(wmod, bmod, modx, modc, (char*)lds, it);
        LAS float* scr = (LAS float*)((LAS unsigned char*)lds + 32768 + wave * 8448);
        constexpr int I_IN = 32 * 145;
        for (int it = gw; it < I_IN; it += NGW) p0_transpose_item(w_in, DM, INPROJ, Win_t, scr, it, lane);
#if !TAILS
        { constexpr int I_OUT = 32 * 64, I_UP = 32 * 352, I_DOWN = 88 * 64;
          for (int it = gw; it < I_OUT + I_UP + I_DOWN; it += NGW) { if (it < I_OUT) p0_transpose_item(w_out, DM, DM, Wout_t, scr, it, lane); else if (it < I_OUT + I_UP) p0_transpose_item(w_up, DM, NUP, Wup_t, scr, it - I_OUT, lane);
              else p0_transpose_item(w_down, DFF, DM, Wdown_t, scr, it - I_OUT - I_UP, lane); } }
#endif
    }
    SEAM(0);
#if XTRA_BAR
    for (int xb_ = 0; xb_ < XTRA_BAR; ++xb_) SEAM(0);
#endif
    for (int rep_ = 0; rep_ < (IN(1) ? 1 + ((REPMASK >> 1) & 1) : 0); ++rep_) { TIDS;
        for (int m = gw; m < MROWS; m += NGW) { const bool isx = m < SEQ; const float* md = isx ? modx : modc;
            norm_mod_row(isx ? x_in + (size_t)m * DM : ctx + (size_t)(m - SEQ) * DM, norm1, md, md + 2048, H + (size_t)m * DM, lane); }
    }
    SEAM(1);
    for (int rep_ = 0; rep_ < (IN(2) ? 1 + ((REPMASK >> 2) & 1) : 0); ++rep_) {
        pg8::Gemm g{H, Win_t, MROWS, NPROJ_PAD, DM}; pg8::StaticOrder S; S.init(MROWS, NPROJ_PAD, G_, bid);
        pg8::EpiInProj E{P, Gt};
        pg8::gemm_phase<pg8::EpiInProj, pg8::StaticOrder, true, true>((LAS unsigned char*)lds, g, S, E);
#if TAILS
        { TIDS; constexpr int NWG = (MROWS / 256) * (NPROJ_PAD / 256); const int R = (NWG + G_ - 1) / G_, thr = NWG - (R - 1) * G_, NL = R * G_ - NWG;
          LAS float* scr = (LAS float*)((LAS unsigned char*)lds + 32768 + wave * 8448);
          constexpr int I_OUT = 32 * 64, I_UP = 32 * 352;
          const int lw = NL > 0 ? (bid - thr) * 8 + wave : gw, nlw = NL > 0 ? NL * 8 : NGW;
          if (NL == 0 || bid >= thr)
              for (int it = lw; it < I_OUT + I_UP; it += nlw) { if (it < I_OUT) p0_transpose_item<false, true>(w_out, DM, DM, Wout_t, scr, it, lane); else p0_transpose_item<false, true>(w_up, DM, NUP, Wup_t, scr, it - I_OUT, lane); } }
#endif
        __syncthreads();
    }
    SEAM(2);
    for (int rep_ = 0; rep_ < (IN(3) ? 1 + ((REPMASK >> 3) & 1) : 0); ++rep_) { TIDS;
        for (int ra_ = 0; ra_ < 1 + REP_A; ++ra_)
        for (int it = bid; it < NSTEP * 4; it += G_) mlstm_passA((char*)lds, P, Gt, b_ig, b_fg, ST, BL, it);
        for (int wi = gw; wi < QK_TASKS / 8; wi += NGW) qk_prep_task(P, wi * 8 + (lane >> 3), qn, kn, lane);
    }
    SEAM(3);
#if PROBE_B
    if (IN(4)) mlstm_passB(ST, BL, (bf16_t*)outp, 7);
#endif
    if (IN(4)) mlstm_passB(ST, BL);
    SEAM(4);
    for (int rep_ = 0; rep_ < (IN(5) ? 1 + ((REPMASK >> 5) & 1) : 0); ++rep_) {
#ifndef P5_SKIP_ATT
        for (int rt_ = 0; rt_ < 1 + REP_ATT; ++rt_)
        for (int u = bid; u < 256; u += G_) { const int hq = u & 7, qb = u >> 3, kvh = hq >> 2;
            att::attn_dense_body(P + (size_t)(qb * 256) * NPROJ + OFF_AQ + hq * 128, P + OFF_AK + kvh * 128, P + OFF_AV + kvh * 128,
                                 MIX + (size_t)(qb * 256) * DM + hq * 128, MROWS, (char*)lds);
            __syncthreads(); }
#endif
#ifndef P5_SKIP_C
        for (int rc_ = 0; rc_ < 1 + REP_C; ++rc_)
        for (int it = bid; it < 128 * 4; it += G_) mlstm_passC((char*)lds, P, Gt, b_ig, b_fg, ST, mnorm, MIX, it);
#endif
    }
    SEAM(5);
    for (int rep_ = 0; rep_ < (IN(6) ? 1 : 0); ++rep_) {
        pg8::Gemm g{MIX, Wout_t, SEQ, DM, DM}; pg8::StaticOrder S; S.init(SEQ, DM, G_, bid);
        if (G_ == 256 && FUSE_NORM) {
            pg8::EpiResidNormMod E{x_in, outp, modx + 4096, norm2, modx + 6144, modx + 8192, H, pg8::RowStats{(float*)(a.ws + WS_SLOT1), (unsigned*)(a.ws + WS_CNT1)}};
            pg8::gemm_phase<pg8::EpiResidNormMod, pg8::StaticOrder, false, true>((LAS unsigned char*)lds, g, S, E);
        } else {
            pg8::EpiResid E{x_in, outp, modx + 4096};
            pg8::gemm_phase<pg8::EpiResid, pg8::StaticOrder, true, true>((LAS unsigned char*)lds, g, S, E);
        }
    }
    if (!(G_ == 256 && FUSE_NORM)) {
    SEAM(6);
    for (int rep_ = 0; rep_ < (IN(7) ? 1 : 0); ++rep_) { TIDS;
        for (int m = gw; m < SEQ; m += NGW) norm_mod_row(outp + (size_t)m * DM, norm2, modx + 6144, modx + 8192, H + (size_t)m * DM, lane);
    }
    }
    SEAM(7);
    for (int rep_ = 0; rep_ < (IN(8) ? 1 + ((REPMASK >> 8) & 1) : 0); ++rep_) {
        pg8::Gemm g{H, Wup_t, SEQ, NUP, DM}; pg8::StaticOrder S; S.init(SEQ, NUP, G_, bid);
        pg8::EpiBf16<0> E{U, NUP};
        pg8::gemm_phase<pg8::EpiBf16<0>, pg8::StaticOrder, true, true>((LAS unsigned char*)lds, g, S, E);
#if TAILS
        { TIDS; constexpr int NWG = (SEQ / 256) * (NUP / 256); const int R = (NWG + G_ - 1) / G_, thr = NWG - (R - 1) * G_, NL = R * G_ - NWG;
          LAS float* scr = (LAS float*)((LAS unsigned char*)lds + 32768 + wave * 8448);
          constexpr int I_DOWN = 88 * 64;
          const int lw = NL > 0 ? (bid - thr) * 8 + wave : gw, nlw = NL > 0 ? NL * 8 : NGW;
          if (NL == 0 || bid >= thr)
              for (int it = lw; it < I_DOWN; it += nlw) p0_transpose_item(w_down, DFF, DM, Wdown_t, scr, it, lane); }
#endif
        __syncthreads();
    }
    SEAM(8);
    for (int rep_ = 0; rep_ < (IN(9) ? 1 + ((REPMASK >> 9) & 1) : 0); ++rep_) { TIDS;
        for (int it = bid * 512 + tid; it < 704 * 512; it += G_ * 512) conv_gate_item(U, convw, convb, ACT, it);
    }
    SEAM(9);
    for (int rep_ = 0; rep_ < (IN(10) ? 1 : 0); ++rep_) {
        pg8::Gemm g{ACT, Wdown_t, SEQ, DM, DFF}; pg8::StaticOrder S; S.init(SEQ, DM, G_, bid);
        if (G_ == 256 && FUSE_NORM) {
            pg8::EpiResidNorm E{outp, outp, modx + 10240, normf, pg8::RowStats{(float*)(a.ws + WS_SLOT2), (unsigned*)(a.ws + WS_CNT2)}};
            pg8::gemm_phase<pg8::EpiResidNorm, pg8::StaticOrder, false, true>((LAS unsigned char*)lds, g, S, E);
        } else {
            pg8::EpiResid E{outp, outp, modx + 10240};
            pg8::gemm_phase<pg8::EpiResid, pg8::StaticOrder, true, true>((LAS unsigned char*)lds, g, S, E);
        }
    }
    if (!(G_ == 256 && FUSE_NORM)) {
    SEAM(10);
    for (int rep_ = 0; rep_ < (IN(11) ? 1 : 0); ++rep_) { TIDS;
        for (int m = gw; m < SEQ; m += NGW) final_norm_row(outp + (size_t)m * DM, normf, lane);
    }
    }
#undef IN
#undef SEAM
#undef x_in
#undef cvec
#undef ctx
#undef cctx
#undef wmod
#undef bmod
#undef norm1
#undef w_in
#undef qn
#undef kn
#undef b_ig
#undef b_fg
#undef mnorm
#undef w_out
#undef norm2
#undef w_up
#undef convw
#undef convb
#undef w_down
#undef normf
#undef outp
#undef modx
#undef modc
#undef BL
#undef Gt
#undef Wdown_t
#undef Win_t
#undef Wout_t
#undef Wup_t
#undef H
#undef MIX
#undef ACT
#undef P
#undef ST
#undef U
}

#ifndef N_LAUNCH_MODE
#define N_LAUNCH_MODE 1
#endif
extern "C" void kernel_launch(void* const* d_in, const int* in_sizes, int n_in, void* d_out, int out_size, void* d_ws, size_t ws_size, hipStream_t stream) {
    static int grid = 0;
    if (grid == 0) {
        if (n_in != 20 || ws_size < WS_END) { fprintf(stderr, "kernel_launch: unexpected n_in %d / ws %zu\n", n_in, ws_size); grid = -1; return; }
        int dev = 0, cus = 0, per_cu = 0;
        hipGetDevice(&dev); hipDeviceGetAttribute(&cus, hipDeviceAttributeMultiprocessorCount, dev);
        hipFuncSetAttribute((const void*)fwd_kernel, hipFuncAttributeMaxDynamicSharedMemorySize, LDS_BYTES);
        hipOccupancyMaxActiveBlocksPerMultiprocessor(&per_cu, (const void*)fwd_kernel, 512, LDS_BYTES);
        if (per_cu < 1) { fprintf(stderr, "kernel_launch: occupancy query says %d blocks/CU\n", per_cu); per_cu = 1; }
        if (per_cu > 1) per_cu = 1;
        grid = cus * per_cu;
    }
    if (grid < 0) return;
    Args a{};
    for (int i = 0; i < 20; ++i) a.in[i] = (const float*)d_in[i];
    a.out = (float*)d_out; a.ws = (unsigned char*)d_ws;
#if N_LAUNCH_MODE == 1
    a.ph_lo = 0; a.ph_hi = NPHASE; a.coop = 1;
    hipMemsetAsync((char*)d_ws + WS_BAR, 0, BAR_BYTES, stream);
    void* args[] = {&a};
    hipError_t e = hipLaunchCooperativeKernel((const void*)fwd_kernel, dim3(grid), dim3(512), args, LDS_BYTES, stream);
    if (e != hipSuccess) fprintf(stderr, "cooperative launch failed: %s (grid %d)\n", hipGetErrorString(e), grid);
#else
    for (int ph = 0; ph < NPHASE; ++ph) { a.ph_lo = ph; a.ph_hi = ph + 1; hipLaunchKernelGGL(fwd_kernel, dim3(grid), dim3(512), LDS_BYTES, stream, a); }
#endif
}
```

```cpp
#include <hip/hip_runtime.h>
#include <hip/hip_cooperative_groups.h>
#include <cstdio>
#include <cstdint>
namespace cg = cooperative_groups;
__device__ __forceinline__ int ltid() { int t = threadIdx.x; asm volatile("" : "+v"(t)); return t; }
namespace pg8 {
#define PG8_LAS __attribute__((address_space(3)))
typedef unsigned short bf16_t;
typedef short bf16x8 __attribute__((ext_vector_type(8)));
typedef float f32x4 __attribute__((ext_vector_type(4)));
typedef unsigned u32x4 __attribute__((ext_vector_type(4)));
constexpr int BM = 256, BK = 64, HALF = 128, HTB = HALF * BK * 2  , STAGE_BYTES = 8 * HTB, NXCD = 8, WGM = 8;

__host__ __device__ __forceinline__ int lds_byte(int r, int c) { const int st = (r >> 4) * 2 + (c >> 5), rr = r & 15, cc = c & 31, ob = rr * 64 + cc * 2; return st * 1024 + (ob ^ (((ob >> 9) & 1) << 5)); }
__host__ __device__ __forceinline__ void stage_rc(int b, int& R, int& C) { const int st = b / 1024, sb = b % 1024, swz = sb ^ (((sb >> 9) & 1) << 5); R = (st >> 1) * 16 + swz / 64; C = (st & 1) * 32 + (swz % 64) / 2; }
__host__ __device__ __forceinline__ int perm32(int rho) { const int n = rho >> 4, i = rho & 15; return 8 * (i >> 2) + 4 * n + (i & 3); }

struct Unit { int pm, pn; };
struct Gemm { const bf16_t* A; const bf16_t* Bt; int M, N, K; int a_rows = 256; };

struct StaticOrder {
    int nM, nN, nwg, G, c;
    __host__ __device__ void init(int M, int N, int G_, int c_) { nM = M / BM; nN = N / BM; nwg = nM * nN; G = G_; c = c_; }
    __host__ __device__ bool next(int i, Unit& u) const {
        const long L = (long)i * G + c; if (L >= nwg) return false;
        int wgid = (int)L; { const int q = nwg / NXCD, r = nwg % NXCD, xcd = wgid % NXCD, off = wgid / NXCD; wgid = (xcd < r ? xcd * (q + 1) : r * (q + 1) + (xcd - r) * q) + off; }
        const int nig = WGM * nN, gid = wgid / nig, fm = gid * WGM, gsz = (nM - fm) < WGM ? (nM - fm) : WGM;
        u.pm = fm + ((wgid % nig) % gsz); u.pn = (wgid % nig) / gsz; return true;
    }
    __device__ __forceinline__ void a_ready(const Unit&) const {}
    __device__ __forceinline__ void done(const Unit&) const {}
};

typedef float f32x2 __attribute__((ext_vector_type(2)));
__device__ __forceinline__ unsigned cvt_pk_bf16(float lo, float hi) { typedef __bf16 bf16x2_ __attribute__((ext_vector_type(2))); const f32x2 v = {lo, hi}; const bf16x2_ b = __builtin_convertvector(v, bf16x2_); return __builtin_bit_cast(unsigned, b); }
#ifndef WT_STORES
#define WT_STORES 0
#endif
#if WT_STORES
__device__ __forceinline__ void st16_wt(void* p, u32x4 v) { asm volatile("global_store_dwordx4 %0, %1, off sc0 sc1" :: "v"(p), "v"(v) : "memory"); }
#else
__device__ __forceinline__ void st16_wt(void* p, u32x4 v) { *(u32x4*)p = v; }
#endif
template <int ACT> struct EpiBf16 {
    static constexpr bool PERM = true, AFTER_DRAIN = false;
    bf16_t* O; int ldc;
    __device__ __forceinline__ void operator()(const f32x4 (&acc)[2][2][4][2], const Unit& u, int wr, int wc, int fr, int fq) const {
        const int row0 = u.pm * BM + wr * 64 + fr; const int col0 = u.pn * BM + wc * 32 + 8 * fq;
#pragma unroll
        for (int ai = 0; ai < 2; ++ai)
#pragma unroll
            for (int m = 0; m < 4; ++m) { bf16_t* rowp = O + (size_t)(row0 + ai * HALF + m * 16) * ldc + col0;
#pragma unroll
                for (int bj = 0; bj < 2; ++bj) { const f32x4 v0 = acc[ai][bj][m][0], v1 = acc[ai][bj][m][1];
                    u32x4 w; w.x = cvt_pk_bf16(v0[0], v0[1]); w.y = cvt_pk_bf16(v0[2], v0[3]); w.z = cvt_pk_bf16(v1[0], v1[1]); w.w = cvt_pk_bf16(v1[2], v1[3]);
                    st16_wt(rowp + bj * HALF, w); } }
    }
};
struct EpiInProj {
    static constexpr bool PERM = true, AFTER_DRAIN = false;
    bf16_t* P; float* G;
    __device__ __forceinline__ void operator()(const f32x4 (&acc)[2][2][4][2], const Unit& u, int wr, int wc, int fr, int fq) const {
        const int row0 = u.pm * BM + wr * 64 + fr; const int pn = u.pn;
        if (pn == 18) {
            if (wc == 0 && fq < 2) {
#pragma unroll
                for (int ai = 0; ai < 2; ++ai)
#pragma unroll
                    for (int m = 0; m < 4; ++m) { float* gp = G + (size_t)(row0 + ai * HALF + m * 16) * 16 + 8 * fq;
                        *(f32x4*)(gp) = acc[ai][0][m][0]; *(f32x4*)(gp + 4) = acc[ai][0][m][1]; }
            }
            return;
        }
        const int col0 = pn * BM + wc * 32 + 8 * fq;
        const int mode = (pn == 8 || pn == 9) ? 1 : (pn >= 14 ? 2 : 0);
#pragma unroll
        for (int ai = 0; ai < 2; ++ai)
#pragma unroll
            for (int m = 0; m < 4; ++m) { bf16_t* rowp = P + (size_t)(row0 + ai * HALF + m * 16) * 4608 + col0;
#pragma unroll
                for (int bj = 0; bj < 2; ++bj) { f32x4 v0 = acc[ai][bj][m][0], v1 = acc[ai][bj][m][1];
                    if (mode == 1) { v0 = v0 * 0.08838834764831845f; v1 = v1 * 0.08838834764831845f; }
                    else if (mode == 2) {
#pragma unroll
                        for (int j = 0; j < 4; ++j) { v0[j] = __builtin_amdgcn_rcpf(1.0f + __builtin_amdgcn_exp2f(-1.4426950408889634f * v0[j])); v1[j] = __builtin_amdgcn_rcpf(1.0f + __builtin_amdgcn_exp2f(-1.4426950408889634f * v1[j])); } }
                    u32x4 w; w.x = cvt_pk_bf16(v0[0], v0[1]); w.y = cvt_pk_bf16(v0[2], v0[3]); w.z = cvt_pk_bf16(v1[0], v1[1]); w.w = cvt_pk_bf16(v1[2], v1[3]);
                    *(u32x4*)(rowp + bj * HALF) = w; } }
    }
};
struct EpiResid {
    static constexpr bool PERM = false, AFTER_DRAIN = false;
    const float* base; float* out; const float* gate;
    __device__ __forceinline__ void operator()(const f32x4 (&acc)[2][2][4][2], const Unit& u, int wr, int wc, int fr, int fq) const {
        const int row0 = u.pm * BM + wr * 64 + fr; const int col0 = u.pn * BM + wc * 32 + 4 * fq;
#pragma unroll
        for (int bj = 0; bj < 2; ++bj)
#pragma unroll
            for (int n = 0; n < 2; ++n) { const f32x4 g = *(const f32x4*)(gate + col0 + bj * HALF + n * 16);
#pragma unroll
                for (int ai = 0; ai < 2; ++ai)
#pragma unroll
                    for (int m = 0; m < 4; ++m) { const size_t off = (size_t)(row0 + ai * HALF + m * 16) * 2048 + col0 + bj * HALF + n * 16;
                        const f32x4 b = *(const f32x4*)(base + off); { const f32x4 o_ = b + g * acc[ai][bj][m][n]; st16_wt(out + off, __builtin_bit_cast(u32x4, o_)); } } }
    }
};
struct RowStats {
    float* slots;
    unsigned* cnt;
    __device__ __forceinline__ void run(const f32x4 (&v)[2][2][4][2], const Unit& u, int wr, int wc, int fr, int fq, PG8_LAS unsigned char* lds, int wid, int lane) const {
        PG8_LAS float* Pp = (PG8_LAS float*)lds;
        PG8_LAS float* S = (PG8_LAS float*)(lds + 4096);
#pragma unroll
        for (int ai = 0; ai < 2; ++ai)
#pragma unroll
            for (int m = 0; m < 4; ++m) { float s = 0.f;
#pragma unroll
                for (int bj = 0; bj < 2; ++bj)
#pragma unroll
                    for (int n = 0; n < 2; ++n) { const f32x4 x = v[ai][bj][m][n]; s += (x[0] * x[0] + x[1] * x[1]) + (x[2] * x[2] + x[3] * x[3]); }
                s += __shfl_xor(s, 16); s += __shfl_xor(s, 32);
                if (fq == 0) Pp[(ai * HALF + wr * 64 + m * 16 + fr) * 4 + wc] = s; }
        asm volatile("s_waitcnt lgkmcnt(0)" ::: "memory"); __builtin_amdgcn_s_barrier(); asm volatile("" ::: "memory");
        const int row = wid * 32 + (lane & 31);
        if (lane < 32) { const float tot = (Pp[row * 4 + 0] + Pp[row * 4 + 1]) + (Pp[row * 4 + 2] + Pp[row * 4 + 3]);
            __hip_atomic_store(slots + (size_t)(u.pm * BM + row) * 8 + u.pn, tot, __ATOMIC_RELAXED, __HIP_MEMORY_SCOPE_AGENT); }
        asm volatile("s_waitcnt vmcnt(0)" ::: "memory");
        if (lane == 0) __hip_atomic_fetch_add(cnt + 64 * u.pm, 1u, __ATOMIC_RELAXED, __HIP_MEMORY_SCOPE_AGENT);
        if (wid == 0) { unsigned sp = 0;
            for (;;) { if ((unsigned)__builtin_amdgcn_readfirstlane(__hip_atomic_load(cnt + 64 * u.pm, __ATOMIC_RELAXED, __HIP_MEMORY_SCOPE_AGENT)) >= 64u) break;
                __builtin_amdgcn_s_sleep(2); if (++sp > (1u << 22)) break; }
            __builtin_amdgcn_fence(__ATOMIC_ACQUIRE, "agent"); }
        asm volatile("s_waitcnt vmcnt(0) lgkmcnt(0)" ::: "memory"); __builtin_amdgcn_s_barrier(); asm volatile("" ::: "memory");
        if (lane < 32) { const float* sl = slots + (size_t)(u.pm * BM + row) * 8; float q = 0.f;
#pragma unroll
            for (int t = 0; t < 8; ++t) q += __hip_atomic_load(sl + t, __ATOMIC_RELAXED, __HIP_MEMORY_SCOPE_AGENT);
            S[row] = rsqrtf(q * (1.0f / 2048.0f) + 1e-6f); }
        asm volatile("s_waitcnt lgkmcnt(0)" ::: "memory"); __builtin_amdgcn_s_barrier(); asm volatile("" ::: "memory");
    }
};
struct EpiResidNorm {
    static constexpr bool PERM = false, AFTER_DRAIN = true;
    const float* base; float* out; const float* gate; const float* gain; RowStats st;
    __device__ __forceinline__ void operator()(const f32x4 (&)[2][2][4][2], const Unit&, int, int, int, int) const {}
    __device__ __forceinline__ void fused(f32x4 (&acc)[2][2][4][2], const Unit& u, int wr, int wc, int fr, int fq, PG8_LAS unsigned char* lds, int wid, int lane) const {
        const int row0 = u.pm * BM + wr * 64 + fr; const int col0 = u.pn * BM + wc * 32 + 4 * fq; size_t off0 = (size_t)row0 * 2048 + col0;
#pragma unroll
        for (int bj = 0; bj < 2; ++bj)
#pragma unroll
            for (int n = 0; n < 2; ++n) { const f32x4 g = *(const f32x4*)(gate + col0 + bj * HALF + n * 16);
#pragma unroll
                for (int ai = 0; ai < 2; ++ai)
#pragma unroll
                    for (int m = 0; m < 4; ++m) { const size_t off = off0 + (size_t)((ai * HALF + m * 16) * 2048 + bj * HALF + n * 16);
                        acc[ai][bj][m][n] = __builtin_nontemporal_load((const f32x4*)(base + off)) + g * acc[ai][bj][m][n];
                        asm volatile("" : "+v"(acc[ai][bj][m][n]));
                        if (m == 3) asm volatile("" ::: "memory"); } }
        st.run(acc, u, wr, wc, fr, fq, lds, wid, lane);
        asm volatile("" : "+v"(off0));
        const PG8_LAS float* S = (const PG8_LAS float*)(lds + 4096);
#pragma unroll
        for (int bj = 0; bj < 2; ++bj)
#pragma unroll
            for (int n = 0; n < 2; ++n) { const f32x4 gn = *(const f32x4*)(gain + col0 + bj * HALF + n * 16);
#pragma unroll
                for (int ai = 0; ai < 2; ++ai)
#pragma unroll
                    for (int m = 0; m < 4; ++m) { const int r = ai * HALF + wr * 64 + m * 16 + fr; const size_t off = off0 + (size_t)((ai * HALF + m * 16) * 2048 + bj * HALF + n * 16);
                        { const f32x4 o_ = acc[ai][bj][m][n] * S[r] * gn; __builtin_nontemporal_store(o_, (f32x4*)(out + off)); } }
                asm volatile("" ::: "memory"); }
    }
};
struct EpiResidNormMod {
    static constexpr bool PERM = false, AFTER_DRAIN = true;
    const float* base; float* out; const float* gate; const float* gain; const float* sh; const float* sc; bf16_t* hn; RowStats st;
    __device__ __forceinline__ void operator()(const f32x4 (&)[2][2][4][2], const Unit&, int, int, int, int) const {}
    __device__ __forceinline__ void fused(f32x4 (&acc)[2][2][4][2], const Unit& u, int wr, int wc, int fr, int fq, PG8_LAS unsigned char* lds, int wid, int lane) const {
        typedef unsigned u32x2_ __attribute__((ext_vector_type(2)));
        const int row0 = u.pm * BM + wr * 64 + fr; const int col0 = u.pn * BM + wc * 32 + 4 * fq; size_t off0 = (size_t)row0 * 2048 + col0;
#pragma unroll
        for (int bj = 0; bj < 2; ++bj)
#pragma unroll
            for (int n = 0; n < 2; ++n) { const f32x4 g = *(const f32x4*)(gate + col0 + bj * HALF + n * 16);
#pragma unroll
                for (int ai = 0; ai < 2; ++ai)
#pragma unroll
                    for (int m = 0; m < 4; ++m) { const size_t off = off0 + (size_t)((ai * HALF + m * 16) * 2048 + bj * HALF + n * 16);
                        const f32x4 x1 = __builtin_nontemporal_load((const f32x4*)(base + off)) + g * acc[ai][bj][m][n]; acc[ai][bj][m][n] = x1; __builtin_nontemporal_store(x1, (f32x4*)(out + off));
                        asm volatile("" : "+v"(acc[ai][bj][m][n]));
                        if (m == 3) asm volatile("" ::: "memory"); } }
        st.run(acc, u, wr, wc, fr, fq, lds, wid, lane);
        asm volatile("" : "+v"(off0));
        const PG8_LAS float* S = (const PG8_LAS float*)(lds + 4096);
#pragma unroll
        for (int bj = 0; bj < 2; ++bj)
#pragma unroll
            for (int n = 0; n < 2; ++n) { const int c = col0 + bj * HALF + n * 16; const f32x4 gn = *(const f32x4*)(gain + c), s1 = *(const f32x4*)(sc + c) + 1.0f, s0 = *(const f32x4*)(sh + c);
#pragma unroll
                for (int ai = 0; ai < 2; ++ai)
#pragma unroll
                    for (int m = 0; m < 4; ++m) { const int r = ai * HALF + wr * 64 + m * 16 + fr; const size_t off = off0 + (size_t)((ai * HALF + m * 16) * 2048 + bj * HALF + n * 16);
                        const f32x4 y = (acc[ai][bj][m][n] * S[r] * gn) * s1 + s0; u32x2_ w; w.x = cvt_pk_bf16(y[0], y[1]); w.y = cvt_pk_bf16(y[2], y[3]); *(u32x2_*)(hn + off) = w; }
                asm volatile("" ::: "memory"); }
    }
};
template <class Epi, class Sched, bool ALIGN_EPI = false, bool SP2 = false>
__device__ __forceinline__ void gemm_phase(PG8_LAS unsigned char* lds, const Gemm g, const Sched& S, const Epi& E) {
    const int tid = ltid(), wid = __builtin_amdgcn_readfirstlane(tid >> 6), lane = tid & 63, wr = wid >> 2, wc = wid & 3, fr = lane & 15, fq = lane >> 4;
    const int K = g.K, nt = K / BK;
    unsigned voffA[2], voffB[2];
#pragma unroll
    for (int i = 0; i < 2; ++i) { int R, C; stage_rc(tid * 16 + i * 8192, R, C); const int Rb = Epi::PERM ? ((R & ~31) + perm32(R & 31)) : R;
        voffA[i] = (unsigned)(R * K + C) * 2u; voffB[i] = (unsigned)(Rb * K + C) * 2u; }
    const size_t kstep = (size_t)(BK * 2);
    const size_t hstep = (size_t)HALF * K * 2;
    const size_t tstep = 2 * hstep; const size_t tstepA = (size_t)g.a_rows * K * 2;
    const unsigned ldsw = (unsigned)wid * 1024u;
    const int aoff = lds_byte(wr * 64 + fr, fq * 8), boff = lds_byte(wc * 32 + fr, fq * 8);
#define PG8_SA(b, h) (((b) * 2 + (h)) * HTB)
#define PG8_SB(b, h) ((4 + (b) * 2 + (h)) * HTB)
#define PG8_STAGE(bufoff, gbase, voff) do { _Pragma("unroll") for (int _i = 0; _i < 2; ++_i) \
        __builtin_amdgcn_global_load_lds((const unsigned*)((const char*)(gbase) + (voff)[_i]), (PG8_LAS unsigned*)(lds + (bufoff) + ldsw + _i * 8192), 16, 0, 0); } while (0)
#define PG8_LDA(dst, b, h) do { _Pragma("unroll") for (int m = 0; m < 4; ++m) _Pragma("unroll") for (int k = 0; k < 2; ++k) dst[m][k] = *(const PG8_LAS bf16x8*)(lds + PG8_SA(b, h) + aoff + m * 2048 + k * 1024); } while (0)
#define PG8_LDB(dst, b, h) do { _Pragma("unroll") for (int n = 0; n < 2; ++n) _Pragma("unroll") for (int k = 0; k < 2; ++k) dst[n][k] = *(const PG8_LAS bf16x8*)(lds + PG8_SB(b, h) + boff + n * 2048 + k * 1024); } while (0)
#define PG8_MMA(ai, bj, At, Bt) do { __builtin_amdgcn_s_setprio(1); _Pragma("unroll") for (int m = 0; m < 4; ++m) _Pragma("unroll") for (int n = 0; n < 2; ++n) _Pragma("unroll") for (int k = 0; k < 2; ++k) \
        acc[ai][bj][m][n] = __builtin_amdgcn_mfma_f32_16x16x32_bf16(Bt[n][k], At[m][k], acc[ai][bj][m][n], 0, 0, 0); __builtin_amdgcn_s_setprio(0); } while (0)
#define PG8_WAIT_V(n) asm volatile("s_waitcnt vmcnt(" #n ")" ::: "memory")
#define PG8_WAIT_L(n) asm volatile("s_waitcnt lgkmcnt(" #n ")" ::: "memory")
#define PG8_BAR __builtin_amdgcn_s_barrier()
#define PG8_SCHED __builtin_amdgcn_sched_barrier(0)
    Unit cur, nxt; int ui = 0;
    if (!S.next(0, cur)) return;
    f32x4 acc[2][2][4][2];
#pragma unroll
    for (int a = 0; a < 2; ++a)
#pragma unroll
        for (int b = 0; b < 2; ++b)
#pragma unroll
            for (int m = 0; m < 4; ++m)
#pragma unroll
                for (int n = 0; n < 2; ++n) acc[a][b][m][n] = (f32x4){0.f, 0.f, 0.f, 0.f};
    bf16x8 At[4][2], B0[2][2], B1[2][2];
    const char* cA = (const char*)g.A + (size_t)cur.pm * tstepA; const char* cB = (const char*)g.Bt + (size_t)cur.pn * tstep;
    S.a_ready(cur);
    if constexpr (SP2) {
        PG8_STAGE(PG8_SB(0, 0), cB, voffB); PG8_STAGE(PG8_SB(0, 1), cB + hstep, voffB); PG8_STAGE(PG8_SA(0, 0), cA, voffA); PG8_STAGE(PG8_SA(0, 1), cA + hstep, voffA);
        if (wr == 1) PG8_BAR;
        PG8_WAIT_V(2); PG8_BAR;
        PG8_STAGE(PG8_SB(1, 0), cB + kstep, voffB); PG8_STAGE(PG8_SA(1, 0), cA + kstep, voffA); PG8_STAGE(PG8_SB(1, 1), cB + hstep + kstep, voffB);
        PG8_WAIT_V(6); PG8_BAR;
    } else {
        PG8_STAGE(PG8_SB(0, 0), cB, voffB); PG8_STAGE(PG8_SA(0, 0), cA, voffA); PG8_STAGE(PG8_SB(0, 1), cB + hstep, voffB); PG8_STAGE(PG8_SA(0, 1), cA + hstep, voffA);
        if (wr == 1) PG8_BAR;
        PG8_WAIT_V(4); PG8_BAR;
        PG8_STAGE(PG8_SB(1, 0), cB + kstep, voffB); PG8_STAGE(PG8_SA(1, 0), cA + kstep, voffA); PG8_STAGE(PG8_SB(1, 1), cB + hstep + kstep, voffB);
        PG8_WAIT_V(6); PG8_BAR;
    }
    for (;;) {
        const bool has_next = S.next(ui + 1, nxt);
        const char* nA = has_next ? (const char*)g.A + (size_t)nxt.pm * tstepA : cA; const char* nB = has_next ? (const char*)g.Bt + (size_t)nxt.pn * tstep : cB;
        for (int t = 0; t < nt; t += 2) {
            const bool last = (t == nt - 2);
            const char* a1 = cA + (size_t)(t + 1) * kstep;
            const char* a2 = last ? nA : cA + (size_t)(t + 2) * kstep; const char* b2 = last ? nB : cB + (size_t)(t + 2) * kstep;
            const char* a3 = a2 + kstep; const char* b3 = b2 + kstep;
            if (last && has_next) S.a_ready(nxt);
            if constexpr (SP2) {
            PG8_LDB(B0, 0, 0); PG8_LDB(B1, 0, 1); PG8_SCHED; PG8_LDA(At, 0, 0); PG8_STAGE(PG8_SA(1, 1), a1 + hstep, voffA);
            PG8_WAIT_V(8); PG8_WAIT_L(0); PG8_BAR; PG8_MMA(0, 0, At, B0); PG8_MMA(0, 1, At, B1); PG8_BAR; PG8_SCHED;
            PG8_LDA(At, 0, 1); PG8_STAGE(PG8_SB(0, 0), b2, voffB); PG8_STAGE(PG8_SB(0, 1), b2 + hstep, voffB); PG8_STAGE(PG8_SA(0, 0), a2, voffA);
            PG8_WAIT_V(8); PG8_WAIT_L(0); PG8_BAR; PG8_MMA(1, 0, At, B0); PG8_MMA(1, 1, At, B1); PG8_BAR; PG8_SCHED;
            PG8_LDB(B0, 1, 0); PG8_LDB(B1, 1, 1); PG8_SCHED; PG8_LDA(At, 1, 0); PG8_STAGE(PG8_SA(0, 1), a2 + hstep, voffA);
            PG8_WAIT_V(8); PG8_WAIT_L(0); PG8_BAR; PG8_MMA(0, 0, At, B0); PG8_MMA(0, 1, At, B1); PG8_BAR; PG8_SCHED;
            PG8_LDA(At, 1, 1); PG8_STAGE(PG8_SB(1, 0), b3, voffB); PG8_STAGE(PG8_SB(1, 1), b3 + hstep, voffB); PG8_STAGE(PG8_SA(1, 0), a3, voffA);
            PG8_WAIT_V(8); PG8_WAIT_L(0); PG8_BAR; PG8_MMA(1, 0, At, B0); PG8_MMA(1, 1, At, B1); PG8_BAR; PG8_SCHED;
            } else {
            PG8_LDB(B0, 0, 0); PG8_SCHED; PG8_LDA(At, 0, 0); PG8_STAGE(PG8_SA(1, 1), a1 + hstep, voffA);
            PG8_WAIT_L(8); PG8_BAR; PG8_WAIT_L(0); PG8_MMA(0, 0, At, B0); PG8_BAR; PG8_SCHED;
            PG8_LDB(B1, 0, 1); PG8_STAGE(PG8_SB(0, 0), b2, voffB);
            PG8_BAR; PG8_WAIT_L(0); PG8_MMA(0, 1, At, B1); PG8_BAR;
            PG8_LDA(At, 0, 1); PG8_STAGE(PG8_SA(0, 0), a2, voffA);
            PG8_BAR; PG8_WAIT_L(0); PG8_MMA(1, 0, At, B0); PG8_BAR; PG8_SCHED;
            PG8_STAGE(PG8_SB(0, 1), b2 + hstep, voffB);
            PG8_WAIT_V(6); PG8_BAR; PG8_MMA(1, 1, At, B1); PG8_BAR;
            PG8_LDB(B0, 1, 0); PG8_SCHED; PG8_LDA(At, 1, 0); PG8_STAGE(PG8_SA(0, 1), a2 + hstep, voffA);
            PG8_WAIT_L(8); PG8_BAR; PG8_WAIT_L(0); PG8_MMA(0, 0, At, B0); PG8_BAR; PG8_SCHED;
            PG8_LDB(B1, 1, 1); PG8_STAGE(PG8_SB(1, 0), b3, voffB);
            PG8_BAR; PG8_WAIT_L(0); PG8_MMA(0, 1, At, B1); PG8_BAR;
            PG8_LDA(At, 1, 1); PG8_STAGE(PG8_SA(1, 0), a3, voffA);
            PG8_BAR; PG8_WAIT_L(0); PG8_MMA(1, 0, At, B0); PG8_BAR; PG8_SCHED;
            PG8_STAGE(PG8_SB(1, 1), b3 + hstep, voffB);
            PG8_WAIT_V(6); PG8_BAR; PG8_MMA(1, 1, At, B1); PG8_BAR;
            }
        }
        if constexpr (ALIGN_EPI) { if (wr == 0) PG8_BAR; }
        if constexpr (!Epi::AFTER_DRAIN) { E(acc, cur, wr, wc, fr, fq); S.done(cur); }
        if (!has_next) break;
#pragma unroll
        for (int a = 0; a < 2; ++a)
#pragma unroll
            for (int b = 0; b < 2; ++b)
#pragma unroll
                for (int m = 0; m < 4; ++m)
#pragma unroll
                    for (int n = 0; n < 2; ++n) acc[a][b][m][n] = (f32x4){0.f, 0.f, 0.f, 0.f};
        cur = nxt; cA = nA; cB = nB; ++ui;
        if constexpr (ALIGN_EPI) { if (wr == 1) PG8_BAR; }
    }
    PG8_WAIT_V(0);
    if constexpr (!ALIGN_EPI) { if (wr == 0) PG8_BAR; }
    PG8_BAR;
    if constexpr (Epi::AFTER_DRAIN) { E.fused(acc, cur, wr, wc, fr, fq, lds, wid, lane); S.done(cur); }
#undef PG8_SA
#undef PG8_SB
#undef PG8_STAGE
#undef PG8_LDA
#undef PG8_LDB
#undef PG8_MMA
#undef PG8_WAIT_V
#undef PG8_WAIT_L
#undef PG8_BAR
#undef PG8_SCHED
}
}
namespace att {
typedef unsigned short bf16;
constexpr int   D = 128, NW = 8, QBLK = 32, KVBLK = 64;
constexpr float SCALE = 0.088388347648318440f;
constexpr float THR = 8.f;
constexpr int LDQ = 4608, LDK = 4608, LDO = 2048;
constexpr size_t SHM_V = KVBLK * D * 2, SHM_K = KVBLK * D * 2, SHM_ATTN = 2 * SHM_V + 2 * SHM_K + NW * 64 * 4;
using bf16x8 = __attribute__((ext_vector_type(8))) short;
using s16x4  = __attribute__((ext_vector_type(4))) short;
using f32x16 = __attribute__((ext_vector_type(16))) float;
using u32x4  = __attribute__((ext_vector_type(4))) unsigned;
#define KSWZ(row, colB) ((row) * 256 + ((colB) ^ (((row) & 7) << 4)))
#define SBAR() __builtin_amdgcn_sched_barrier(0)
__device__ __forceinline__ int crow(int r, int hi) { return (r & 3) + 8 * (r >> 2) + 4 * hi; }
__device__ __forceinline__ unsigned cvtpk(float lo, float hi) {
  unsigned r; asm volatile("v_cvt_pk_bf16_f32 %0, %1, %2" : "=v"(r) : "v"(lo), "v"(hi)); return r;
}
__device__ __forceinline__ bf16x8 ld8(const bf16* p) { return *reinterpret_cast<const bf16x8*>(p); }
__device__ __forceinline__ void partialSM(f32x16& p0, f32x16& p1, float& m_reg, float& mn, float& alpha) {
  constexpr float C = SCALE * 1.4426950408889634f;
  float pmax = p0[0]; for (int r = 1; r < 16; ++r) pmax = fmaxf(pmax, p0[r]); for (int r = 0; r < 16; ++r) pmax = fmaxf(pmax, p1[r]);
  { auto rr = __builtin_amdgcn_permlane32_swap(__float_as_uint(pmax), __float_as_uint(pmax), false, false);
    pmax = fmaxf(__uint_as_float(rr[0]), __uint_as_float(rr[1])); }
  if (__builtin_expect(__all(pmax - m_reg <= THR / SCALE), 1)) { mn = m_reg; alpha = 1.f; }
  else { mn = fmaxf(m_reg, pmax); alpha = __builtin_amdgcn_exp2f((m_reg - mn) * C); m_reg = mn; }
  float mnC = -mn * C;
  for (int r = 0; r < 16; ++r) p0[r] = fmaf(p0[r], C, mnC); for (int r = 0; r < 16; ++r) p1[r] = fmaf(p1[r], C, mnC);
  for (int r = 0; r < 16; ++r) p0[r] = __builtin_amdgcn_exp2f(p0[r]);
}
#define PK4(P, BASE, OUT) do { unsigned a0 = cvtpk(P[BASE + 0], P[BASE + 1]), a1 = cvtpk(P[BASE + 2], P[BASE + 3]);   \
    unsigned b0 = cvtpk(P[BASE + 4], P[BASE + 5]), b1 = cvtpk(P[BASE + 6], P[BASE + 7]);                              \
    auto r0 = __builtin_amdgcn_permlane32_swap(a0, b0, false, false); auto r1 = __builtin_amdgcn_permlane32_swap(a1, b1, false, false); \
    u32x4 w = {r0[0], r1[0], r0[1], r1[1]}; OUT = *reinterpret_cast<bf16x8*>(&w); } while (0)
__device__ __forceinline__ void finishSM(f32x16& p0, f32x16& p1, float alpha, float& l_reg, bf16x8& pa0, bf16x8& pa1, bf16x8& pa2, bf16x8& pa3) {
  for (int r = 0; r < 16; ++r) p1[r] = __builtin_amdgcn_exp2f(p1[r]);
  float ps = 0; for (int r = 0; r < 16; ++r) ps += p0[r]; for (int r = 0; r < 16; ++r) ps += p1[r];
  { auto rr = __builtin_amdgcn_permlane32_swap(__float_as_uint(ps), __float_as_uint(ps), false, false);
    ps = __uint_as_float(rr[0]) + __uint_as_float(rr[1]); }
  l_reg = l_reg * alpha + ps;
  PK4(p0, 0, pa0); PK4(p0, 8, pa1); PK4(p1, 0, pa2); PK4(p1, 8, pa3);
}
__device__ __forceinline__ void qkt(f32x16& p0, f32x16& p1, const bf16* Ks, const bf16x8* qr, int r32, int hi) {
  p0 = f32x16{}; p1 = f32x16{};
  for (int d0 = 0; d0 < 8; ++d0) { int cb = (d0 * 16 + hi * 8) * 2;
    bf16x8 b0 = *reinterpret_cast<const bf16x8*>((const char*)Ks + KSWZ(r32, cb));
    bf16x8 b1 = *reinterpret_cast<const bf16x8*>((const char*)Ks + KSWZ(32 + r32, cb));
    p0 = __builtin_amdgcn_mfma_f32_32x32x16_bf16(b0, qr[d0], p0, 0, 0, 0);
    p1 = __builtin_amdgcn_mfma_f32_32x32x16_bf16(b1, qr[d0], p1, 0, 0, 0); }
}
__device__ __forceinline__ int v_st(int k, int c) { const int kk = (k & ~0xC) | ((k & 4) << 1) | ((k & 8) >> 1); return ((kk >> 3) * 4 + (c >> 5)) * 512 + ((kk & 7) * 32 + (c & 31)) * 2; }
__device__ __forceinline__ int v_rd_base(int lane) { return ((lane & 3) << 3) | (((lane >> 2) & 3) << 6) | (((lane >> 4) & 1) << 5) | (((lane >> 5) & 1) << 8); }
constexpr int v_rd_off(int d0, int ks, int half) { return d0 * 512 + ks * 4096 + half * 2048; }
template <int OFF> __device__ __forceinline__ s16x4 tr_read(int vb) {
  s16x4 r; asm volatile("ds_read_b64_tr_b16 %0, %1 offset:%2" : "=&v"(r) : "v"(vb), "i"(OFF) : "memory"); return r;
}
template <int D0> __device__ __forceinline__ void pv_one(f32x16& od, int vb, bf16x8 pa0, bf16x8 pa1, bf16x8 pa2, bf16x8 pa3) {
  const s16x4 l0 = tr_read<v_rd_off(D0, 0, 0)>(vb), h0 = tr_read<v_rd_off(D0, 0, 1)>(vb), l1 = tr_read<v_rd_off(D0, 1, 0)>(vb), h1 = tr_read<v_rd_off(D0, 1, 1)>(vb);
  const s16x4 l2 = tr_read<v_rd_off(D0, 2, 0)>(vb), h2 = tr_read<v_rd_off(D0, 2, 1)>(vb), l3 = tr_read<v_rd_off(D0, 3, 0)>(vb), h3 = tr_read<v_rd_off(D0, 3, 1)>(vb);
  asm volatile("s_waitcnt lgkmcnt(0)" ::: "memory"); SBAR();
#define PK(L, H) (bf16x8){L[0], L[1], L[2], L[3], H[0], H[1], H[2], H[3]}
  od = __builtin_amdgcn_mfma_f32_32x32x16_bf16(pa0, PK(l0, h0), od, 0, 0, 0);
  od = __builtin_amdgcn_mfma_f32_32x32x16_bf16(pa1, PK(l1, h1), od, 0, 0, 0);
  od = __builtin_amdgcn_mfma_f32_32x32x16_bf16(pa2, PK(l2, h2), od, 0, 0, 0);
  od = __builtin_amdgcn_mfma_f32_32x32x16_bf16(pa3, PK(l3, h3), od, 0, 0, 0);
#undef PK
}
__device__ __forceinline__ void pv_d0(f32x16* o, int vb, bf16x8 pa0, bf16x8 pa1, bf16x8 pa2, bf16x8 pa3) {
  pv_one<0>(o[0], vb, pa0, pa1, pa2, pa3); pv_one<1>(o[1], vb, pa0, pa1, pa2, pa3); pv_one<2>(o[2], vb, pa0, pa1, pa2, pa3); pv_one<3>(o[3], vb, pa0, pa1, pa2, pa3);
}
__device__ __forceinline__ void attn_dense_body(const bf16* __restrict__ Qb, const bf16* __restrict__ Kh, const bf16* __restrict__ Vh,
                                                bf16* __restrict__ Ob, int seq, char* lds) {
  const int tid = ltid(), wid = tid >> 6, lane = tid & 63, r32 = lane & 31, hi = lane >> 5;
  bf16* V_lds = (bf16*)lds; bf16* K_lds = (bf16*)(lds + 2 * SHM_V);
  float* ws = (float*)(lds + 2 * SHM_V + 2 * SHM_K) + wid * 64; float* li_l = ws; float* al_l = ws + 32;
  float m_reg = -1e30f, l_reg = 0; f32x16 o[4] = {}; bf16x8 qr[8];
  const bf16* Qw = Qb + (long)(wid * QBLK + r32) * LDQ + hi * 8;
#pragma unroll
  for (int d0 = 0; d0 < 8; ++d0) qr[d0] = __builtin_nontemporal_load(reinterpret_cast<const bf16x8*>(Qw + d0 * 16));
  const int sr = tid >> 4, sc = (tid & 15) * 8, vst0 = v_st(sr, sc), vst1 = v_st(32 + sr, sc);
  const int vb0 = (int)(uintptr_t)V_lds + v_rd_base(lane);
  struct { bf16x8 vs0, vs1, ks0, ks1; } sr_[1];
#define SLOAD(i, k0) do { sr_[i].vs0 = ld8(&Vh[(long)((k0) + sr) * LDK + sc]); sr_[i].vs1 = ld8(&Vh[(long)((k0) + 32 + sr) * LDK + sc]); \
    sr_[i].ks0 = ld8(&Kh[(long)((k0) + sr) * LDK + sc]); sr_[i].ks1 = ld8(&Kh[(long)((k0) + 32 + sr) * LDK + sc]); } while (0)
#define SWRITE(b, i) do { *(bf16x8*)((char*)V_lds + (b) * SHM_V + vst0) = sr_[i].vs0;          \
    *(bf16x8*)((char*)V_lds + (b) * SHM_V + vst1) = sr_[i].vs1; int kc = sc * 2;               \
    *(bf16x8*)((char*)K_lds + (b) * SHM_K + KSWZ(sr, kc)) = sr_[i].ks0;                       \
    *(bf16x8*)((char*)K_lds + (b) * SHM_K + KSWZ(32 + sr, kc)) = sr_[i].ks1; } while (0)
#define SWAIT() do { asm volatile("s_waitcnt vmcnt(0)" ::: "memory"); } while (0)
#define RESC(a) do { if (__any((a) < 1.f)) { if (hi == 0) al_l[r32] = (a); asm volatile("s_waitcnt lgkmcnt(0)" ::: "memory"); \
    for (int d = 0; d < 4; ++d) for (int r = 0; r < 16; ++r) o[d][r] *= al_l[crow(r, hi)]; } } while (0)
  f32x16 pA0, pA1, pB0, pB1; float mnA, mnB, alA, alB; bf16x8 pa0, pa1, pa2, pa3; const int NT = seq / KVBLK;
  constexpr int SE = 0, SO = 0;
  SLOAD(SE, 0); asm volatile("s_waitcnt vmcnt(0)" ::: "memory"); SWRITE(0, SE); __syncthreads();
  qkt(pA0, pA1, K_lds, qr, r32, hi); partialSM(pA0, pA1, m_reg, mnA, alA);
  SLOAD(SO, KVBLK);
  SWAIT(); SWRITE(1, SO); __syncthreads();
  for (int j = 1; j + 1 < NT; j += 2) {
    SBAR(); qkt(pB0, pB1, (bf16*)((char*)K_lds + SHM_K), qr, r32, hi);
    finishSM(pA0, pA1, alA, l_reg, pa0, pa1, pa2, pa3); SBAR();
    SLOAD(SO, (j + 1) * KVBLK); SBAR();
    pv_d0(o, vb0, pa0, pa1, pa2, pa3); partialSM(pB0, pB1, m_reg, mnB, alB);
    __syncthreads(); SWAIT(); SWRITE(0, SE);
    RESC(alB); __syncthreads();
    SBAR(); qkt(pA0, pA1, K_lds, qr, r32, hi);
    finishSM(pB0, pB1, alB, l_reg, pa0, pa1, pa2, pa3); SBAR();
    SLOAD(SE, (j + 2) * KVBLK); SBAR();
    pv_d0(o, vb0 + (int)SHM_V, pa0, pa1, pa2, pa3); partialSM(pA0, pA1, m_reg, mnA, alA);
    __syncthreads(); SWAIT(); SWRITE(1, SO);
    RESC(alA); __syncthreads();
  }
  SBAR(); qkt(pB0, pB1, (bf16*)((char*)K_lds + SHM_K), qr, r32, hi);
  finishSM(pA0, pA1, alA, l_reg, pa0, pa1, pa2, pa3); SBAR();
  pv_d0(o, vb0, pa0, pa1, pa2, pa3); partialSM(pB0, pB1, m_reg, mnB, alB);
  __syncthreads(); RESC(alB);
  finishSM(pB0, pB1, alB, l_reg, pa0, pa1, pa2, pa3); SBAR();
  pv_d0(o, vb0 + (int)SHM_V, pa0, pa1, pa2, pa3);
  if (hi == 0) li_l[r32] = l_reg; asm volatile("s_waitcnt lgkmcnt(0)" ::: "memory");
  float rli[16];
#pragma unroll
  for (int r = 0; r < 16; ++r) rli[r] = __builtin_amdgcn_rcpf(li_l[crow(r, hi)]);
  bf16* Ow = Ob + (long)(wid * QBLK) * LDO;
#pragma unroll
  for (int r = 0; r < 16; ++r) { int orow = crow(r, hi);
    for (int d0 = 0; d0 < 4; ++d0) { const float v = o[d0][r] * rli[r]; Ow[(long)orow * LDO + d0 * 32 + r32] = (bf16)(cvtpk(v, v) & 0xffffu); } }
#undef SLOAD
#undef SWRITE
#undef SWAIT
#undef RESC
}
}
#define LAS __attribute__((address_space(3)))
#define XB_TMO      128
#define XB_XCNT(j)  (256  + 64 * (j))
#define XB_XSUB(j)  (1280 + 64 * (j))
#define XB_XGEN(j)  (2304 + 64 * (j))
#define XB_TOP      3328
#define XB_TOPGEN   3392
#define XCD_BAR_WORDS 3456
#define XB_SPIN_CAP (1u << 18)

__device__ __forceinline__ unsigned xb_ld(unsigned* p)              { return __hip_atomic_load(p, __ATOMIC_RELAXED, __HIP_MEMORY_SCOPE_AGENT); }
__device__ __forceinline__ unsigned xb_add(unsigned* p, unsigned v) { return __hip_atomic_fetch_add(p, v, __ATOMIC_RELAXED, __HIP_MEMORY_SCOPE_AGENT); }
__device__ __forceinline__ unsigned xb_xcc_id() { return (unsigned)__builtin_amdgcn_s_getreg((3 << 11) | 20) & 0xFu; }
#define XB_SPIN(cond, bar) do { unsigned _sp = 0; while (cond) { __builtin_amdgcn_s_sleep(1); \
    if ((++_sp & 255u) == 0u) { if (xb_ld(&(bar)[XB_TMO])) break; if (_sp > XB_SPIN_CAP) { atomicAdd(&(bar)[XB_TMO], 1u); break; } } } } while (0)

struct XcdBarrier {
    unsigned* bar; unsigned x;
    volatile LAS unsigned* st;
};

__device__ __forceinline__ XcdBarrier xcd_barrier_post(unsigned* bar, volatile LAS unsigned* st) {
    XcdBarrier b; b.bar = bar; b.x = xb_xcc_id(); b.st = st;
    if (threadIdx.x == 0) (void)xb_add(&bar[XB_XCNT(b.x)], 1u);
    return b;
}
__device__ __forceinline__ void xcd_barrier_complete(unsigned* bar, unsigned x, unsigned& nloc, unsigned& nx) {
    const unsigned G = gridDim.x * gridDim.y * gridDim.z;
    unsigned sum, cnt, mine, sp = 0u;
    for (;;) {
        sum = 0u; cnt = 0u; mine = 0u;
#pragma unroll
        for (unsigned j = 0; j < 16; ++j) { const unsigned c = xb_ld(&bar[XB_XCNT(j)]); sum += c; cnt += (c > 0u) ? 1u : 0u; mine = (j == x) ? c : mine; }
        if (sum == G) break;
        __builtin_amdgcn_s_sleep(1);
        if ((++sp & 255u) == 0u) { if (xb_ld(&bar[XB_TMO])) break; if (sp > XB_SPIN_CAP) { atomicAdd(&bar[XB_TMO], 1u); break; } }
    }
    nloc = mine > 0u ? mine : 1u; nx = cnt > 0u ? cnt : 1u;
}

__device__ __forceinline__ void xcd_barrier(const XcdBarrier& b) {
    asm volatile("s_waitcnt vmcnt(0)" ::: "memory");
    __syncthreads();
    if (threadIdx.x == 0) {
        unsigned* bar = b.bar;
        __builtin_amdgcn_s_waitcnt(0);
        unsigned nloc = b.st[0], nx = b.st[1];
        if (nloc == 0u) { xcd_barrier_complete(bar, b.x, nloc, nx); b.st[0] = nloc; b.st[1] = nx; }
        const unsigned old = xb_add(&bar[XB_XSUB(b.x)], 1u);
        const unsigned gen = old / nloc;
        if (old + 1u == (gen + 1u) * nloc) {
            __builtin_amdgcn_fence(__ATOMIC_RELEASE, "agent");
            asm volatile("s_waitcnt vmcnt(0)" ::: "memory");
            const unsigned og = xb_add(&bar[XB_TOP], 1u);
            const unsigned tg = og / nx;
            if (og + 1u == (tg + 1u) * nx) xb_add(&bar[XB_TOPGEN], 1u);
            else XB_SPIN(xb_ld(&bar[XB_TOPGEN]) == tg, bar);
            __builtin_amdgcn_fence(__ATOMIC_ACQUIRE, "agent");
            xb_add(&bar[XB_XGEN(b.x)], 1u);
            asm volatile("s_waitcnt vmcnt(0)" ::: "memory");
        } else {
            XB_SPIN(xb_ld(&bar[XB_XGEN(b.x)]) == gen, bar);
            __builtin_amdgcn_fence(__ATOMIC_ACQUIRE, "agent");
            asm volatile("s_waitcnt vmcnt(0)" ::: "memory");
        }
    }
    __syncthreads();
}
typedef unsigned short bf16_t;
typedef float f32x4 __attribute__((ext_vector_type(4)));
typedef unsigned u32x4 __attribute__((ext_vector_type(4)));
typedef unsigned u32x2 __attribute__((ext_vector_type(2)));
using att::bf16x8; using att::s16x4; using att::f32x16; using att::crow; using att::cvtpk;

constexpr int DM = 2048, SEQ = 8192, CTXL = 256, MROWS = SEQ + CTXL  , NPROJ = 4608, NPROJ_PAD = 4864, INPROJ = 4624, DFF = 5632, NUP = 2 * DFF;
constexpr int OFF_AQ = 0, OFF_AK = 1024, OFF_AV = 1280, OFF_MQ = 1536, OFF_MK = 2048, OFF_MV = 2560, OFF_MO = 3584;
constexpr float EPS = 1e-6f;
constexpr int NSTEP = 132, SROWS = 257; constexpr size_t ST_BLK = (size_t)SROWS * 128;
constexpr size_t MiB = 1u << 20;
constexpr size_t WS_MODX = 0, WS_MODC = 64 * 1024, WS_BL = 128 * 1024, WS_G = 256 * 1024, WS_BAR = 1 * MiB, BAR_BYTES = 65536, WS_CNT1 = 1 * MiB + 16384, WS_CNT2 = 1 * MiB + 32768, WS_SLOT1 = 1 * MiB + 256 * 1024, WS_SLOT2 = 1 * MiB + 512 * 1024;
constexpr size_t WS_WDOWN = 2 * MiB, WS_WIN = 24 * MiB, WS_WOUT = 43 * MiB, WS_WUP = 51 * MiB, WS_H = 95 * MiB, WS_MIX = 128 * MiB, WS_ACT = 24 * MiB;
constexpr size_t WS_P = 160 * MiB, WS_ST = 235 * MiB, WS_U = 160 * MiB, WS_TILE = 256 * MiB, WS_END = 368 * MiB;
constexpr int LDS_BYTES = 131072 + 1024;
constexpr int NPHASE = 12;
#ifndef FLATBAR
#define FLATBAR 0
#endif
#ifndef XTRA_BAR
#define XTRA_BAR 0
#endif
#ifndef REP_ATT
#define REP_ATT 0
#endif
#ifndef PROBE_B
#define PROBE_B 0
#endif
#ifndef PROBE_10
#define PROBE_10 0
#endif
#ifndef FUSE_NORM
#define FUSE_NORM 1
#endif
#ifndef REP_C
#define REP_C 0
#define REP_A 0
#endif
#ifndef REPMASK
#define REPMASK 0
#endif
#ifndef TAILS
#define TAILS 1
#endif

__device__ __forceinline__ float bf2f(unsigned v) { return __uint_as_float(v << 16); }
typedef float f32x2_t __attribute__((ext_vector_type(2))); typedef __bf16 bf16x2_t __attribute__((ext_vector_type(2)));
__device__ __forceinline__ unsigned pkbf(float lo, float hi) { const f32x2_t v = {lo, hi}; const bf16x2_t b = __builtin_convertvector(v, bf16x2_t); return __builtin_bit_cast(unsigned, b); }
__device__ __forceinline__ float wave_sum(float v) {
#pragma unroll
    for (int o = 1; o < 64; o <<= 1) v += __shfl_xor(v, o);
    return v;
}
__device__ __forceinline__ float log_sigmoid(float x) { return fminf(x, 0.f) - log1pf(__expf(-fabsf(x))); }

template <bool UPPERM = false, bool NTST = false> __device__ __forceinline__ void p0_transpose_item(const float* W, int K, int N, bf16_t* WT, LAS float* scr, int item, int lane) {
    const int nblk = (N + 31) / 32, kb = item / nblk, nb = item % nblk, k0 = 64 * kb, n0 = 32 * nb;
    const int nd0 = UPPERM ? (n0 < 5632 ? (n0 >> 7) * 256 + (n0 & 127) : ((n0 - 5632) >> 7) * 256 + 128 + ((n0 - 5632) & 127)) : n0;
    const int c4 = (lane & 7) * 4, kr = lane >> 3; const bool okc = n0 + c4 < N;
    f32x4 v[8];
#pragma unroll
    for (int i = 0; i < 8; ++i) v[i] = okc ? __builtin_nontemporal_load((const f32x4*)(W + (size_t)(k0 + kr + 8 * i) * N + n0 + c4)) : (f32x4){0.f, 0.f, 0.f, 0.f};
#pragma unroll
    for (int i = 0; i < 8; ++i) { LAS float* d = scr + (kr + 8 * i) * 33 + c4; d[0] = v[i].x; d[1] = v[i].y; d[2] = v[i].z; d[3] = v[i].w; }
    asm volatile("s_waitcnt lgkmcnt(0)" ::: "memory");
    const int c = lane & 7;
#pragma unroll
    for (int j = 0; j < 4; ++j) { const int n = (lane >> 3) + 8 * j; const LAS float* s = scr + (8 * c) * 33 + n;
        u32x4 o; o.x = pkbf(s[0 * 33], s[1 * 33]); o.y = pkbf(s[2 * 33], s[3 * 33]); o.z = pkbf(s[4 * 33], s[5 * 33]); o.w = pkbf(s[6 * 33], s[7 * 33]);
        if (NTST) __builtin_nontemporal_store(o, (u32x4*)(WT + (size_t)(nd0 + n) * K + k0 + 8 * c)); else *(u32x4*)(WT + (size_t)(nd0 + n) * K + k0 + 8 * c) = o; }
    asm volatile("s_waitcnt lgkmcnt(0)" ::: "memory");
}
__device__ __forceinline__ void p0_gemv_item(const float* wmod, const float* bmod, float* modx, float* modc, char* lds, int item) {
    const int tid = ltid(); const float* sx = (const float*)lds; const float* sc = sx + 2048; float* red = (float*)(lds + 16384);
    const int n0 = item * 64, c4 = (tid & 15) * 4, kr = tid >> 4;
    f32x4 ax = {0.f, 0.f, 0.f, 0.f}, ac = {0.f, 0.f, 0.f, 0.f};
#pragma unroll 8
    for (int j = 0; j < 64; ++j) { const int k = kr + 32 * j; const f32x4 w = __builtin_nontemporal_load((const f32x4*)(wmod + (size_t)k * 12288 + n0 + c4)); ax += w * sx[k]; ac += w * sc[k]; }
    *(f32x4*)(red + (kr * 16 + (tid & 15)) * 8) = ax; *(f32x4*)(red + (kr * 16 + (tid & 15)) * 8 + 4) = ac;
    __syncthreads();
    if (tid < 128) { const int col = tid & 63, which = tid >> 6; float s = 0.f;
        for (int k2 = 0; k2 < 32; ++k2) s += red[(k2 * 16 + (col >> 2)) * 8 + which * 4 + (col & 3)];
        s += bmod[n0 + col]; (which ? modc : modx)[n0 + col] = s; }
    __syncthreads();
}
__device__ __forceinline__ void norm_mod_row(const float* xrow, const float* g, const float* sh, const float* sc, bf16_t* orow, int lane) {
    const f32x4* xr = (const f32x4*)xrow + lane; f32x4 v[8]; float s = 0.f;
#pragma unroll
    for (int j = 0; j < 8; ++j) { v[j] = __builtin_nontemporal_load(xr + 64 * j); s += (v[j].x * v[j].x + v[j].y * v[j].y) + (v[j].z * v[j].z + v[j].w * v[j].w); }
    const float rstd = rsqrtf(wave_sum(s) * (1.f / 2048.f) + EPS);
    u32x2* o8 = (u32x2*)orow + lane;
#pragma unroll
    for (int j = 0; j < 8; ++j) { const f32x4 gg = ((const f32x4*)g)[lane + 64 * j], s1 = ((const f32x4*)sc)[lane + 64 * j], s0 = ((const f32x4*)sh)[lane + 64 * j];
        const f32x4 y = (v[j] * rstd * gg) * (s1 + 1.0f) + s0; u32x2 w; w.x = pkbf(y.x, y.y); w.y = pkbf(y.z, y.w); o8[64 * j] = w; }
}
__device__ __forceinline__ void final_norm_row(float* xrow, const float* g, int lane) {
    f32x4* xr = (f32x4*)xrow + lane; f32x4 v[8]; float s = 0.f;
#pragma unroll
    for (int j = 0; j < 8; ++j) { v[j] = xr[64 * j]; s += (v[j].x * v[j].x + v[j].y * v[j].y) + (v[j].z * v[j].z + v[j].w * v[j].w); }
    const float rstd = rsqrtf(wave_sum(s) * (1.f / 2048.f) + EPS);
#pragma unroll
    for (int j = 0; j < 8; ++j) { const f32x4 gg = ((const f32x4*)g)[lane + 64 * j]; xr[64 * j] = v[j] * rstd * gg; }
}
constexpr int QK_TASKS = SEQ * 10 + CTXL * 2;
__device__ __forceinline__ void qk_prep_task(bf16_t* P, int t, const float* qn, const float* kn, int lane) {
    int row, hh; if (t < SEQ * 10) { row = t / 10; hh = t - row * 10; } else { const int t2 = t - SEQ * 10; row = SEQ + (t2 >> 1); hh = 8 + (t2 & 1); }
    const bool is_x = row < SEQ; const int sl = lane & 7, half = sl >> 2, i0 = (sl & 3) * 8, e1 = 64 * half + i0;
    bf16_t* hp = P + (size_t)row * NPROJ + (hh < 8 ? OFF_AQ + hh * 128 : OFF_AK + (hh - 8) * 128) + e1;
    const u32x4 ra = *(const u32x4*)hp, rb = *(const u32x4*)(hp + 32);
    const float* gn = (hh < 8 ? qn : kn) + e1;
    const f32x4 ga0 = *(const f32x4*)gn, ga1 = *(const f32x4*)(gn + 4), gb0 = *(const f32x4*)(gn + 32), gb1 = *(const f32x4*)(gn + 36);
    float x1[8], x2[8]; float ss = 0.f;
#pragma unroll
    for (int j = 0; j < 4; ++j) { x1[2 * j] = __uint_as_float(ra[j] << 16); x1[2 * j + 1] = __uint_as_float(ra[j] & 0xffff0000u); x2[2 * j] = __uint_as_float(rb[j] << 16); x2[2 * j + 1] = __uint_as_float(rb[j] & 0xffff0000u); }
#pragma unroll
    for (int j = 0; j < 8; ++j) ss += x1[j] * x1[j] + x2[j] * x2[j];
    ss += __shfl_xor(ss, 1); ss += __shfl_xor(ss, 2); ss += __shfl_xor(ss, 4);
    const float rstd = rsqrtf(ss * (1.f / 128.f) + EPS);
    const float pos = (float)(half == 0 ? (row >> 6) : (row & 63));
    float o1[8], o2[8];
#pragma unroll
    for (int j = 0; j < 8; ++j) {
        float cs = 1.f, sn = 0.f;
        if (is_x) { const float invf = exp2f(-(float)(i0 + j) * (13.287712379549449f / 32.0f));
            const float rev = pos * invf * 0.15915494309189535f; cs = __builtin_amdgcn_cosf(rev); sn = __builtin_amdgcn_sinf(rev); }
        const float y1 = x1[j] * rstd * (j < 4 ? ga0[j & 3] : ga1[j & 3]), y2 = x2[j] * rstd * (j < 4 ? gb0[j & 3] : gb1[j & 3]);
        o1[j] = y1 * cs - y2 * sn; o2[j] = y2 * cs + y1 * sn; }
    u32x4 wa, wb;
#pragma unroll
    for (int j = 0; j < 4; ++j) { wa[j] = pkbf(o1[2 * j], o1[2 * j + 1]); wb[j] = pkbf(o2[2 * j], o2[2 * j + 1]); }
    if (hh < 8) { __builtin_nontemporal_store(wa, (u32x4*)hp); __builtin_nontemporal_store(wb, (u32x4*)(hp + 32)); }
    else { *(u32x4*)hp = wa; *(u32x4*)(hp + 32) = wb; }
}
__device__ __forceinline__ void gate_scan(const float* G, const float* b_i, const float* b_f, int row0, int h, int dir, int lane, float& b, float& ip, float& bL) {
    const float* g = G + (size_t)(row0 + lane) * 16 + dir * 8;
    ip = g[h] + b_i[dir * 4 + h];
    b = log_sigmoid(g[4 + h] + b_f[dir * 4 + h]);
    if (dir == 0) {
#pragma unroll
        for (int o = 1; o < 64; o <<= 1) { const float v = __shfl_up(b, o); if (lane >= o) b += v; }
        bL = __shfl(b, 63);
    } else {
#pragma unroll
        for (int o = 1; o < 64; o <<= 1) { const float v = __shfl_down(b, o); if (lane + o < 64) b += v; }
        bL = __shfl(b, 0);
    }
}
__device__ __forceinline__ s16x4 vtr(const LAS char* p) { typedef short v4i16_t __attribute__((ext_vector_type(4)));
    return __builtin_bit_cast(s16x4, __builtin_amdgcn_ds_read_tr16_b64_v4i16((LAS v4i16_t*)p)); }
__device__ __forceinline__ bf16x8 trfrag(const LAS char* base, int off) { const s16x4 l = vtr(base + off), h = vtr(base + off + 2048);
    return (bf16x8){l[0], l[1], l[2], l[3], h[0], h[1], h[2], h[3]}; }
__device__ __forceinline__ bf16x8 scale8(bf16x8 k, float w) { const u32x4 u = __builtin_bit_cast(u32x4, k); u32x4 o;
#pragma unroll
    for (int j = 0; j < 4; ++j) o[j] = pkbf(__uint_as_float(u[j] << 16) * w, __uint_as_float(u[j] & 0xffff0000u) * w);
    return __builtin_bit_cast(bf16x8, o); }
__device__ __forceinline__ bf16x8 pack8(f32x4 a, f32x4 b) { u32x4 o; o.x = pkbf(a.x, a.y); o.y = pkbf(a.z, a.w); o.z = pkbf(b.x, b.y); o.w = pkbf(b.z, b.w); return __builtin_bit_cast(bf16x8, o); }
__device__ __forceinline__ int step_of(int dir, int c) { return dir == 0 ? (c < 128 ? c + 4 : c - 128) : 131 - c; }

__device__ __forceinline__ void mlstm_passA(char* lds, const bf16_t* P, const float* G, const float* b_i, const float* b_f, bf16_t* ST, float* BL, int item) {
    const int tid = ltid(), wid = tid >> 6, lane = tid & 63, r32 = lane & 31, hi = lane >> 5;
    const int c = item >> 2, h = item & 3, row0 = c * 64;
    float* wts = (float*)(lds + 65536);
    if (wid < 2) { float b, ip, bL; gate_scan(G, b_i, b_f, row0, h, wid, lane, b, ip, bL); wts[wid * 64 + lane] = __expf(bL - b + ip);
        if (lane == 0) BL[(wid * 4 + h) * NSTEP + step_of(wid, c)] = bL; }
    __syncthreads();
#pragma unroll
    for (int i = 0; i < 4; ++i) { const int p = tid + 512 * i, r = p >> 5, cc = (p & 31) * 8;
        const bf16x8 v = *(const bf16x8*)(P + (size_t)(row0 + r) * NPROJ + OFF_MV + h * 256 + cc);
        *(bf16x8*)(lds + (cc >> 7) * 16384 + att::v_st(r, cc & 127)) = v; }
#pragma unroll
    for (int i = 0; i < 2; ++i) { const int p = tid + 512 * i, r = p >> 4, cc = (p & 15) * 8;
        const bf16x8 k = *(const bf16x8*)(P + (size_t)(row0 + r) * NPROJ + OFF_MK + h * 128 + cc);
        *(bf16x8*)(lds + 32768 + att::v_st(r, cc)) = scale8(k, wts[r]); *(bf16x8*)(lds + 49152 + att::v_st(r, cc)) = scale8(k, wts[64 + r]); }
    __syncthreads();
    const int dir = wid >> 2, cb = wid & 3;
    const LAS char* L = (const LAS char*)lds + att::v_rd_base(lane);
    const LAS char* La = L + (cb >> 1) * 16384 + ((2 * cb) & 3) * 512;
    const LAS char* Lb = L + 32768 + dir * 16384;
    bf16_t* base = ST + ((size_t)(dir * 4 + h) * NSTEP + step_of(dir, c)) * ST_BLK;
#pragma nounroll
    for (int a = 0; a < 2; ++a) {
        f32x16 acc[4];
#pragma unroll
        for (int b = 0; b < 4; ++b) acc[b] = f32x16{};
        const LAS char* Laa = La + a * 512;
#pragma unroll
        for (int ks = 0; ks < 4; ++ks) {
            const bf16x8 A = trfrag(Laa, ks * 4096);
#pragma unroll
            for (int b = 0; b < 4; ++b) acc[b] = __builtin_amdgcn_mfma_f32_32x32x16_bf16(A, trfrag(Lb, b * 512 + ks * 4096), acc[b], 0, 0, 0);
        }
#pragma unroll
        for (int b = 0; b < 4; ++b)
#pragma unroll
            for (int r = 0; r < 16; ++r) base[(size_t)(64 * cb + 32 * a + crow(r, hi)) * 128 + 32 * b + r32] = (bf16_t)(pkbf(acc[b][r], acc[b][r]) & 0xffffu);
    }
    if (cb == 0) {
        f32x16 an[4];
#pragma unroll
        for (int b = 0; b < 4; ++b) an[b] = f32x16{};
        const short one = (r32 == 0) ? (short)0x3F80 : (short)0; const bf16x8 A1 = {one, one, one, one, one, one, one, one};
#pragma unroll
        for (int ks = 0; ks < 4; ++ks)
#pragma unroll
            for (int b = 0; b < 4; ++b) an[b] = __builtin_amdgcn_mfma_f32_32x32x16_bf16(A1, trfrag(Lb, b * 512 + ks * 4096), an[b], 0, 0, 0);
        if (hi == 0) {
#pragma unroll
            for (int b = 0; b < 4; ++b) base[(size_t)256 * 128 + 32 * b + r32] = (bf16_t)(pkbf(an[b][0], an[b][0]) & 0xffffu);
        }
    }
    __syncthreads();
}
__device__ __forceinline__ void mlstm_passB(bf16_t* ST, const float* BL, bf16_t* DST = nullptr, int ndh = 8) {
    constexpr int PER = (int)(ST_BLK / 2); constexpr size_t SB = ST_BLK / 2;
    const int nthr = gridDim.x * 512;
    for (int e = blockIdx.x * 512 + ltid(); e < ndh * PER; e += nthr) {
        const int dh = e / PER, idx = e - dh * PER;
        unsigned* p = (unsigned*)(ST + (size_t)dh * NSTEP * ST_BLK) + idx; const float* bl = BL + dh * NSTEP;
        unsigned* q = DST ? (unsigned*)(DST + (size_t)dh * NSTEP * ST_BLK) + idx : p;
        float c0 = 0.f, c1 = 0.f;
        unsigned cur[12], nxt[12];
#pragma unroll
        for (int j = 0; j < 12; ++j) cur[j] = p[(size_t)j * SB];
        for (int s = 0; s < NSTEP; s += 12) {
#pragma unroll
            for (int j = 0; j < 12; ++j) nxt[j] = (s + 12 + j < NSTEP) ? p[(size_t)(s + 12 + j) * SB] : 0u;
#pragma unroll
            for (int j = 0; j < 12; ++j) { const float d = __expf(bl[s + j]);
                q[(size_t)(s + j) * SB] = pkbf(c0, c1);
                c0 = c0 * d + __uint_as_float(cur[j] << 16); c1 = c1 * d + __uint_as_float(cur[j] & 0xffff0000u); }
#pragma unroll
            for (int j = 0; j < 12; ++j) cur[j] = nxt[j];
        }
    }
}
__device__ __forceinline__ void mlstm_passC(char* lds, const bf16_t* P, const float* G, const float* b_i, const float* b_f, const bf16_t* ST, const float* mnorm, bf16_t* MIX, int item) {
    const int tid = ltid(), wid = tid >> 6, lane = tid & 63, r32 = lane & 31, hi = lane >> 5;
    const int c = item >> 2, h = item & 3, row0 = c * 64;
    float* bq = (float*)(lds + 49152); float* ak = bq + 128; float* eq = ak + 128; float* ssq = eq + 128;
    if (wid < 2) { float b, ip, bL; gate_scan(G, b_i, b_f, row0, h, wid, lane, b, ip, bL); bq[wid * 64 + lane] = b; ak[wid * 64 + lane] = b - ip; eq[wid * 64 + lane] = __expf(b); }
    { const int sr = tid >> 4, sc = (tid & 15) * 8;
#pragma unroll
      for (int i = 0; i < 2; ++i) { const int r = sr + 32 * i; const bf16x8 k = *(const bf16x8*)(P + (size_t)(row0 + r) * NPROJ + OFF_MK + h * 128 + sc);
          *(bf16x8*)(lds + KSWZ(r, sc * 2)) = k; } }
#pragma unroll
    for (int i = 0; i < 4; ++i) { const int p = tid + 512 * i, r = p >> 5, cc = (p & 31) * 8;
        const bf16x8 v = *(const bf16x8*)(P + (size_t)(row0 + r) * NPROJ + OFF_MV + h * 256 + cc);
        *(bf16x8*)(lds + 16384 + (cc >> 7) * 16384 + att::v_st(r, cc & 127)) = v; }
    const int rb = wid >> 2, cb = wid & 3, q = 32 * rb + r32;
    bf16x8 qr[8];
    { const bf16_t* Qw = P + (size_t)(row0 + q) * NPROJ + OFF_MQ + h * 128 + hi * 8;
#pragma unroll
      for (int d0 = 0; d0 < 8; ++d0) qr[d0] = *(const bf16x8*)(Qw + d0 * 16); }
    bf16x8 fr[3][8];
#define LOAD_FR(d) do { const bf16_t* base_ = ST + ((size_t)((d) * 4 + h) * NSTEP + step_of((d), c)) * ST_BLK; \
        _Pragma("unroll") for (int t = 0; t < 3; ++t) { const bf16_t* src = base_ + (size_t)(t < 2 ? 64 * cb + 32 * t + r32 : 256) * 128 + 8 * hi; \
            _Pragma("unroll") for (int ks = 0; ks < 8; ++ks) { fr[t][ks] = (bf16x8){0, 0, 0, 0, 0, 0, 0, 0}; if (t < 2 || r32 == 0) fr[t][ks] = *(const bf16x8*)(src + 16 * ks); } } } while (0)
    LOAD_FR(0);
    __syncthreads();
    f32x16 acc[2][3];
#pragma unroll
    for (int d = 0; d < 2; ++d)
#pragma unroll
        for (int t = 0; t < 3; ++t) acc[d][t] = f32x16{};
#pragma unroll
    for (int d = 0; d < 2; ++d) {
        if (d == 1) LOAD_FR(1);
#pragma unroll
        for (int t = 0; t < 3; ++t)
#pragma unroll
            for (int ks = 0; ks < 8; ++ks) acc[d][t] = __builtin_amdgcn_mfma_f32_32x32x16_bf16(qr[ks], fr[t][ks], acc[d][t], 0, 0, 0);
#pragma unroll
        for (int r = 0; r < 16; ++r) { const float e = eq[d * 64 + 32 * rb + crow(r, hi)];
#pragma unroll
            for (int t = 0; t < 3; ++t) acc[d][t][r] *= e; }
    }
#undef LOAD_FR
    float ogv[2][16], mnv[2];
#pragma unroll
    for (int t = 0; t < 2; ++t) { const int col = 64 * cb + 32 * t + r32; mnv[t] = mnorm[h * 256 + col];
#pragma unroll
        for (int r = 0; r < 16; ++r) ogv[t][r] = bf2f(P[(size_t)(row0 + 32 * rb + crow(r, hi)) * NPROJ + OFF_MO + h * 256 + col]); }
    f32x16 p0, p1; att::qkt(p0, p1, (const bf16_t*)lds, qr, r32, hi);
    const LAS char* Lv = (const LAS char*)lds + 16384 + att::v_rd_base(lane) + (cb >> 1) * 16384 + ((2 * cb) & 3) * 512;
    const short one = (r32 == 0) ? (short)0x3F80 : (short)0; const bf16x8 B1 = {one, one, one, one, one, one, one, one};
#pragma unroll
    for (int d = 0; d < 2; ++d) {
        const float bqv = bq[d * 64 + q]; f32x16 e0, e1;
#pragma unroll
        for (int r = 0; r < 16; ++r) { const int k0 = crow(r, hi), k1 = 32 + k0;
            const bool v0 = d == 0 ? (k0 <= q) : (k0 >= q), v1 = d == 0 ? (k1 <= q) : (k1 >= q);
            const float x0 = __expf(bqv - ak[d * 64 + k0]), x1 = __expf(bqv - ak[d * 64 + k1]);
            e0[r] = v0 ? p0[r] * x0 : 0.f; e1[r] = v1 ? p1[r] * x1 : 0.f; }
        bf16x8 pa0, pa1, pa2, pa3; PK4(e0, 0, pa0); PK4(e0, 8, pa1); PK4(e1, 0, pa2); PK4(e1, 8, pa3);
#pragma unroll
        for (int t = 0; t < 2; ++t) {
            acc[d][t] = __builtin_amdgcn_mfma_f32_32x32x16_bf16(pa0, trfrag(Lv, t * 512 + 0 * 4096), acc[d][t], 0, 0, 0);
            acc[d][t] = __builtin_amdgcn_mfma_f32_32x32x16_bf16(pa1, trfrag(Lv, t * 512 + 1 * 4096), acc[d][t], 0, 0, 0);
            acc[d][t] = __builtin_amdgcn_mfma_f32_32x32x16_bf16(pa2, trfrag(Lv, t * 512 + 2 * 4096), acc[d][t], 0, 0, 0);
            acc[d][t] = __builtin_amdgcn_mfma_f32_32x32x16_bf16(pa3, trfrag(Lv, t * 512 + 3 * 4096), acc[d][t], 0, 0, 0);
        }
        acc[d][2] = __builtin_amdgcn_mfma_f32_32x32x16_bf16(pa0, B1, acc[d][2], 0, 0, 0);
        acc[d][2] = __builtin_amdgcn_mfma_f32_32x32x16_bf16(pa1, B1, acc[d][2], 0, 0, 0);
        acc[d][2] = __builtin_amdgcn_mfma_f32_32x32x16_bf16(pa2, B1, acc[d][2], 0, 0, 0);
        acc[d][2] = __builtin_amdgcn_mfma_f32_32x32x16_bf16(pa3, B1, acc[d][2], 0, 0, 0);
    }
    f32x16 hv[2];
#pragma unroll
    for (int r = 0; r < 16; ++r) {
        const int f0 = __builtin_amdgcn_readlane(__float_as_int(acc[0][2][r]), 0), f1 = __builtin_amdgcn_readlane(__float_as_int(acc[0][2][r]), 32);
        const int g0 = __builtin_amdgcn_readlane(__float_as_int(acc[1][2][r]), 0), g1 = __builtin_amdgcn_readlane(__float_as_int(acc[1][2][r]), 32);
        const float df = __int_as_float(hi ? f1 : f0), db = __int_as_float(hi ? g1 : g0);
        const float invf = __builtin_amdgcn_rcpf(fmaxf(fabsf(df), 1.0f)), invb = __builtin_amdgcn_rcpf(fmaxf(fabsf(db), 1.0f));
        hv[0][r] = acc[0][0][r] * invf + acc[1][0][r] * invb; hv[1][r] = acc[0][1][r] * invf + acc[1][1][r] * invb;
    }
    { float s16[16];
#pragma unroll
      for (int r = 0; r < 16; ++r) s16[r] = hv[0][r] * hv[0][r] + hv[1][r] * hv[1][r];
      float s8[8], s4[4], s2[2], s1;
#pragma unroll
      for (int r = 0; r < 8; ++r) { const float keep = (lane & 16) ? s16[8 + r] : s16[r], give = (lane & 16) ? s16[r] : s16[8 + r]; s8[r] = keep + __shfl_xor(give, 16); }
#pragma unroll
      for (int r = 0; r < 4; ++r) { const float keep = (lane & 8) ? s8[4 + r] : s8[r], give = (lane & 8) ? s8[r] : s8[4 + r]; s4[r] = keep + __shfl_xor(give, 8); }
#pragma unroll
      for (int r = 0; r < 2; ++r) { const float keep = (lane & 4) ? s4[2 + r] : s4[r], give = (lane & 4) ? s4[r] : s4[2 + r]; s2[r] = keep + __shfl_xor(give, 4); }
      { const float keep = (lane & 2) ? s2[1] : s2[0], give = (lane & 2) ? s2[0] : s2[1]; s1 = keep + __shfl_xor(give, 2); }
      s1 += __shfl_xor(s1, 1);
      const int rr = ((lane >> 4) & 1) * 8 + ((lane >> 3) & 1) * 4 + ((lane >> 2) & 1) * 2 + ((lane >> 1) & 1);
      if ((lane & 1) == 0) ssq[cb * 64 + 32 * rb + crow(rr, hi)] = s1; }
    __syncthreads();
#pragma unroll
    for (int r = 0; r < 16; ++r) { const int row = 32 * rb + crow(r, hi); const float rstd = rsqrtf(((ssq[row] + ssq[64 + row]) + (ssq[128 + row] + ssq[192 + row])) * (1.f / 256.f) + EPS);
#pragma unroll
        for (int t = 0; t < 2; ++t) { const int col = 64 * cb + 32 * t + r32;
            const float val = hv[t][r] * rstd * mnv[t] * ogv[t][r];
            MIX[(size_t)(row0 + row) * DM + 1024 + h * 256 + col] = (bf16_t)(pkbf(val, val) & 0xffffu); } }
    __syncthreads();
}
__device__ __forceinline__ void conv_gate_item(const bf16_t* U, const float* cw, const float* cbias, bf16_t* ACT, int item) {
    const int cgp = item % 704, rr = item / 704, j0 = cgp * 8, t0 = rr * 16;
    float w0g[8], w1g[8], w2g[8], bg[8], w0v[8], w1v[8], w2v[8], bv[8];
#pragma unroll
    for (int j = 0; j < 8; ++j) { w0g[j] = cw[j0 + j]; w1g[j] = cw[NUP + j0 + j]; w2g[j] = cw[2 * NUP + j0 + j]; bg[j] = cbias[j0 + j];
        w0v[j] = cw[DFF + j0 + j]; w1v[j] = cw[NUP + DFF + j0 + j]; w2v[j] = cw[2 * NUP + DFF + j0 + j]; bv[j] = cbias[DFF + j0 + j]; }
    const u32x4 z = {0u, 0u, 0u, 0u};
    u32x4 pg = z, pv = z;
    if (t0 > 0) { pg = __builtin_nontemporal_load((const u32x4*)(U + (size_t)(t0 - 1) * NUP + j0)); pv = __builtin_nontemporal_load((const u32x4*)(U + (size_t)(t0 - 1) * NUP + DFF + j0)); }
    u32x4 cg_ = __builtin_nontemporal_load((const u32x4*)(U + (size_t)t0 * NUP + j0)), cv = __builtin_nontemporal_load((const u32x4*)(U + (size_t)t0 * NUP + DFF + j0));
    for (int t = t0; t < t0 + 16; ++t) {
        u32x4 ng = z, nv = z;
        if (t + 1 < SEQ) { ng = __builtin_nontemporal_load((const u32x4*)(U + (size_t)(t + 1) * NUP + j0)); nv = __builtin_nontemporal_load((const u32x4*)(U + (size_t)(t + 1) * NUP + DFF + j0)); }
        u32x4 o;
#pragma unroll
        for (int jj = 0; jj < 4; ++jj) {
            float r2[2];
#pragma unroll
            for (int e = 0; e < 2; ++e) { const int j = 2 * jj + e;
                const float a = e ? __uint_as_float(pg[jj] & 0xffff0000u) : __uint_as_float(pg[jj] << 16);
                const float b = e ? __uint_as_float(cg_[jj] & 0xffff0000u) : __uint_as_float(cg_[jj] << 16);
                const float d = e ? __uint_as_float(ng[jj] & 0xffff0000u) : __uint_as_float(ng[jj] << 16);
                const float av = e ? __uint_as_float(pv[jj] & 0xffff0000u) : __uint_as_float(pv[jj] << 16);
                const float bvv = e ? __uint_as_float(cv[jj] & 0xffff0000u) : __uint_as_float(cv[jj] << 16);
                const float dv = e ? __uint_as_float(nv[jj] & 0xffff0000u) : __uint_as_float(nv[jj] << 16);
                const float gc = w0g[j] * a + w1g[j] * b + w2g[j] * d + bg[j];
                const float vc = w0v[j] * av + w1v[j] * bvv + w2v[j] * dv + bv[j];
                r2[e] = gc * __builtin_amdgcn_rcpf(1.0f + __builtin_amdgcn_exp2f(-1.4426950408889634f * gc)) * vc; }
            o[jj] = pkbf(r2[0], r2[1]); }
        *(u32x4*)(ACT + (size_t)t * DFF + j0) = o;
        pg = cg_; pv = cv; cg_ = ng; cv = nv;
    }
}

__device__ __forceinline__ void flat_barrier(unsigned* cnt, unsigned target) {
    asm volatile("s_waitcnt vmcnt(0)" ::: "memory");
    __syncthreads();
    if (threadIdx.x == 0) {
        __builtin_amdgcn_fence(__ATOMIC_RELEASE, "agent");
        asm volatile("s_waitcnt vmcnt(0)" ::: "memory");
        __hip_atomic_fetch_add(cnt, 1u, __ATOMIC_RELAXED, __HIP_MEMORY_SCOPE_AGENT);
        unsigned sp = 0;
        while (__hip_atomic_load(cnt, __ATOMIC_RELAXED, __HIP_MEMORY_SCOPE_AGENT) < target) { __builtin_amdgcn_s_sleep(1); if (++sp > (1u << 22)) break; }
        __builtin_amdgcn_fence(__ATOMIC_ACQUIRE, "agent");
        asm volatile("s_waitcnt vmcnt(0)" ::: "memory");
    }
    __syncthreads();
}
struct Args { const float* in[20]; float* out; unsigned char* ws; int ph_lo, ph_hi, coop, pad; };

__global__ void __launch_bounds__(512) fwd_kernel(Args a) {
    extern __shared__ __attribute__((aligned(16))) unsigned char lds[];
    const int G_ = gridDim.x, bid = blockIdx.x; const int NGW = G_ * 8;
#define TIDS const int tid = ltid(), lane = tid & 63, wave = __builtin_amdgcn_readfirstlane(tid >> 6), gw = bid * 8 + wave; (void)tid; (void)lane; (void)gw
#define x_in (a.in[0])
#define cvec (a.in[1])
#define ctx (a.in[2])
#define cctx (a.in[3])
#define wmod (a.in[4])
#define bmod (a.in[5])
#define norm1 (a.in[6])
#define w_in (a.in[7])
#define qn (a.in[8])
#define kn (a.in[9])
#define b_ig (a.in[10])
#define b_fg (a.in[11])
#define mnorm (a.in[12])
#define w_out (a.in[13])
#define norm2 (a.in[14])
#define w_up (a.in[15])
#define convw (a.in[16])
#define convb (a.in[17])
#define w_down (a.in[18])
#define normf (a.in[19])
#define outp (a.out)
#define modx ((float*)(a.ws + WS_MODX))
#define modc ((float*)(a.ws + WS_MODC))
#define BL ((float*)(a.ws + WS_BL))
#define Gt ((float*)(a.ws + WS_G))
#define Wdown_t ((bf16_t*)(a.ws + WS_WDOWN))
#define Win_t ((bf16_t*)(a.ws + WS_WIN))
#define Wout_t ((bf16_t*)(a.ws + WS_WOUT))
#define Wup_t ((bf16_t*)(a.ws + WS_WUP))
#define H ((bf16_t*)(a.ws + WS_H))
#define MIX ((bf16_t*)(a.ws + WS_MIX))
#define ACT ((bf16_t*)(a.ws + WS_ACT))
#define P ((bf16_t*)(a.ws + WS_P))
#define ST ((bf16_t*)(a.ws + WS_ST))
#define U ((bf16_t*)(a.ws + WS_U))
    const int lo = a.ph_lo, hi_ = a.ph_hi;
#ifndef PH_MASK
#define PH_MASK 0xfff
#endif
#define IN(k) (((PH_MASK >> (k)) & 1) && lo <= (k) && (k) < hi_)
#if FLATBAR
    unsigned bar_epoch = 0;
#define SEAM(k) do { if (IN(k) && IN((k) + 1)) { bar_epoch += gridDim.x; flat_barrier((unsigned*)(a.ws + WS_BAR) + 64, bar_epoch); } } while (0)
#else
#define SEAM(k) do { if (IN(k) && IN((k) + 1)) xcd_barrier(bar); } while (0)
#endif
    if (threadIdx.x < 32) ((volatile LAS unsigned*)((LAS unsigned char*)lds + 131072))[threadIdx.x] = 0u;
    __syncthreads();
    XcdBarrier bar; bar.bar = (unsigned*)(a.ws + WS_BAR); bar.x = 0; bar.st = nullptr;
    if (a.coop) { bar = xcd_barrier_post((unsigned*)(a.ws + WS_BAR), (volatile LAS unsigned*)((LAS unsigned char*)lds + 131072)); cg::this_grid().sync(); }

    for (int rep_ = 0; rep_ < (IN(0) ? 1 + ((REPMASK >> 0) & 1) : 0); ++rep_) { TIDS;
        float* sx = (float*)lds;
        for (int i = tid; i < 2048; i += 512) { const float v = cvec[i]; sx[i] = v / (1.0f + __expf(-v)); const float w = cctx[i]; sx[2048 + i] = w / (1.0f + __expf(-w)); }
        __syncthreads();
        for (int it = bid; it < 192; it += G_) p0_gemv_item(wmod, bmod, modx, modc, (char*)lds, it);
        LAS float* scr = (LAS float*)((LAS unsigned char*)lds + 32768 + wave * 8448);
        constexpr int I_IN = 32 * 145;
        for (int it = gw; it < I_IN; it += NGW) p0_transpose_item(w_in, DM, INPROJ, Win_t, scr, it, lane);
#if !TAILS
        { constexpr int I_OUT = 32 * 64, I_UP = 32 * 352, I_DOWN = 88 * 64;
          for (int it = gw; it < I_OUT + I_UP + I_DOWN; it += NGW) { if (it < I_OUT) p0_transpose_item(w_out, DM, DM, Wout_t, scr, it, lane); else if (it < I_OUT + I_UP) p0_transpose_item(w_up, DM, NUP, Wup_t, scr, it - I_OUT, lane);
              else p0_transpose_item(w_down, DFF, DM, Wdown_t, scr, it - I_OUT - I_UP, lane); } }
#endif
    }
    SEAM(0);
#if XTRA_BAR
    for (int xb_ = 0; xb_ < XTRA_BAR; ++xb_) SEAM(0);
#endif
    for (int rep_ = 0; rep_ < (IN(1) ? 1 + ((REPMASK >> 1) & 1) : 0); ++rep_) { TIDS;
        for (int m = gw; m < MROWS; m += NGW) { const bool isx = m < SEQ; const float* md = isx ? modx : modc;
            norm_mod_row(isx ? x_in + (size_t)m * DM : ctx + (size_t)(m - SEQ) * DM, norm1, md, md + 2048, H + (size_t)m * DM, lane); }
    }
    SEAM(1);
    for (int rep_ = 0; rep_ < (IN(2) ? 1 + ((REPMASK >> 2) & 1) : 0); ++rep_) {
        pg8::Gemm g{H, Win_t, MROWS, NPROJ_PAD, DM}; pg8::StaticOrder S; S.init(MROWS, NPROJ_PAD, G_, bid);
        pg8::EpiInProj E{P, Gt};
        pg8::gemm_phase<pg8::EpiInProj, pg8::StaticOrder, true, true>((LAS unsigned char*)lds, g, S, E);
#if TAILS
        { TIDS; constexpr int NWG = (MROWS / 256) * (NPROJ_PAD / 256); const int R = (NWG + G_ - 1) / G_, thr = NWG - (R - 1) * G_, NL = R * G_ - NWG;
          LAS float* scr = (LAS float*)((LAS unsigned char*)lds + 32768 + wave * 8448);
          constexpr int I_OUT = 32 * 64, I_UP = 32 * 352;
          const int lw = NL > 0 ? (bid - thr) * 8 + wave : gw, nlw = NL > 0 ? NL * 8 : NGW;
          if (NL == 0 || bid >= thr)
              for (int it = lw; it < I_OUT + I_UP; it += nlw) { if (it < I_OUT) p0_transpose_item<false, true>(w_out, DM, DM, Wout_t, scr, it, lane); else p0_transpose_item<false, true>(w_up, DM, NUP, Wup_t, scr, it - I_OUT, lane); } }
#endif
        __syncthreads();
    }
    SEAM(2);
    for (int rep_ = 0; rep_ < (IN(3) ? 1 + ((REPMASK >> 3) & 1) : 0); ++rep_) { TIDS;
        for (int ra_ = 0; ra_ < 1 + REP_A; ++ra_)
        for (int it = bid; it < NSTEP * 4; it += G_) mlstm_passA((char*)lds, P, Gt, b_ig, b_fg, ST, BL, it);
        for (int wi = gw; wi < QK_TASKS / 8; wi += NGW) qk_prep_task(P, wi * 8 + (lane >> 3), qn, kn, lane);
    }
    SEAM(3);
#if PROBE_B
    if (IN(4)) mlstm_passB(ST, BL, (bf16_t*)outp, 7);
#endif
    if (IN(4)) mlstm_passB(ST, BL);
    SEAM(4);
    for (int rep_ = 0; rep_ < (IN(5) ? 1 + ((REPMASK >> 5) & 1) : 0); ++rep_) {
#ifndef P5_SKIP_ATT
        for (int rt_ = 0; rt_ < 1 + REP_ATT; ++rt_)
        for (int u = bid; u < 256; u += G_) { const int hq = u & 7, qb = u >> 3, kvh = hq >> 2;
            att::attn_dense_body(P + (size_t)(qb * 256) * NPROJ + OFF_AQ + hq * 128, P + OFF_AK + kvh * 128, P + OFF_AV + kvh * 128,
                                 MIX + (size_t)(qb * 256) * DM + hq * 128, MROWS, (char*)lds);
            __syncthreads(); }
#endif
#ifndef P5_SKIP_C
        for (int rc_ = 0; rc_ < 1 + REP_C; ++rc_)
        for (int it = bid; it < 128 * 4; it += G_) mlstm_passC((char*)lds, P, Gt, b_ig, b_fg, ST, mnorm, MIX, it);
#endif
    }
    SEAM(5);
    for (int rep_ = 0; rep_ < (IN(6) ? 1 : 0); ++rep_) {
        pg8::Gemm g{MIX, Wout_t, SEQ, DM, DM}; pg8::StaticOrder S; S.init(SEQ, DM, G_, bid);
        if (G_ == 256 && FUSE_NORM) {
            pg8::EpiResidNormMod E{x_in, outp, modx + 4096, norm2, modx + 6144, modx + 8192, H, pg8::RowStats{(float*)(a.ws + WS_SLOT1), (unsigned*)(a.ws + WS_CNT1)}};
            pg8::gemm_phase<pg8::EpiResidNormMod, pg8::StaticOrder, false, true>((LAS unsigned char*)lds, g, S, E);
        } else {
            pg8::EpiResid E{x_in, outp, modx + 4096};
            pg8::gemm_phase<pg8::EpiResid, pg8::StaticOrder, true, true>((LAS unsigned char*)lds, g, S, E);
        }
    }
    if (!(G_ == 256 && FUSE_NORM)) {
    SEAM(6);
    for (int rep_ = 0; rep_ < (IN(7) ? 1 : 0); ++rep_) { TIDS;
        for (int m = gw; m < SEQ; m += NGW) norm_mod_row(outp + (size_t)m * DM, norm2, modx + 6144, modx + 8192, H + (size_t)m * DM, lane);
    }
    }
    SEAM(7);
    for (int rep_ = 0; rep_ < (IN(8) ? 1 + ((REPMASK >> 8) & 1) : 0); ++rep_) {
        pg8::Gemm g{H, Wup_t, SEQ, NUP, DM}; pg8::StaticOrder S; S.init(SEQ, NUP, G_, bid);
        pg8::EpiBf16<0> E{U, NUP};
        pg8::gemm_phase<pg8::EpiBf16<0>, pg8::StaticOrder, true, true>((LAS unsigned char*)lds, g, S, E);
#if TAILS
        { TIDS; constexpr int NWG = (SEQ / 256) * (NUP / 256); const int R = (NWG + G_ - 1) / G_, thr = NWG - (R - 1) * G_, NL = R * G_ - NWG;
          LAS float* scr = (LAS float*)((LAS unsigned char*)lds + 32768 + wave * 8448);
          constexpr int I_DOWN = 88 * 64;
          const int lw = NL > 0 ? (bid - thr) * 8 + wave : gw, nlw = NL > 0 ? NL * 8 : NGW;
          if (NL == 0 || bid >= thr)
              for (int it = lw; it < I_DOWN; it += nlw) p0_transpose_item(w_down, DFF, DM, Wdown_t, scr, it, lane); }
#endif
        __syncthreads();
    }
    SEAM(8);
    for (int rep_ = 0; rep_ < (IN(9) ? 1 + ((REPMASK >> 9) & 1) : 0); ++rep_) { TIDS;
        for (int it = bid * 512 + tid; it < 704 * 512; it += G_ * 512) conv_gate_item(U, convw, convb, ACT, it);
    }
    SEAM(9);
    for (int rep_ = 0; rep_ < (IN(10) ? 1 : 0); ++rep_) {
        pg8::Gemm g{ACT, Wdown_t, SEQ, DM, DFF}; pg8::StaticOrder S; S.init(SEQ, DM, G_, bid);
        if (G_ == 256 && FUSE_NORM) {
            pg8::EpiResidNorm E{outp, outp, modx + 10240, normf, pg8::RowStats{(float*)(a.ws + WS_SLOT2), (unsigned*)(a.ws + WS_CNT2)}};
            pg8::gemm_phase<pg8::EpiResidNorm, pg8::StaticOrder, false, true>((LAS unsigned char*)lds, g, S, E);
        } else {
            pg8::EpiResid E{outp, outp, modx + 10240};
            pg8::gemm_phase<pg8::EpiResid, pg8::StaticOrder, true, true>((LAS unsigned char*)lds, g, S, E);
        }
    }
    if (!(G_ == 256 && FUSE_NORM)) {
    SEAM(10);
    for (int rep_ = 0; rep_ < (IN(11) ? 1 : 0); ++rep_) { TIDS;
        for (int m = gw; m < SEQ; m += NGW) final_norm_row(outp + (size_t)m * DM, normf, lane);
    }
    }
#undef IN
#undef SEAM
#undef x_in
#undef cvec
#undef ctx
#undef cctx
#undef wmod
#undef bmod
#undef norm1
#undef w_in
#undef qn
#undef kn
#undef b_ig
#undef b_fg
#undef mnorm
#undef w_out
#undef norm2
#undef w_up
#undef convw
#undef convb
#undef w_down
#undef normf
#undef outp
#undef modx
#undef modc
#undef BL
#undef Gt
#undef Wdown_t
#undef Win_t
#undef Wout_t
#undef Wup_t
#undef H
#undef MIX
#undef ACT
#undef P
#undef ST
#undef U
}

#ifndef N_LAUNCH_MODE
#define N_LAUNCH_MODE 1
#endif
extern "C" void kernel_launch(void* const* d_in, const int* in_sizes, int n_in, void* d_out, int out_size, void* d_ws, size_t ws_size, hipStream_t stream) {
    static int grid = 0;
    if (grid == 0) {
        if (n_in != 20 || ws_size < WS_END) { fprintf(stderr, "kernel_launch: unexpected n_in %d / ws %zu\n", n_in, ws_size); grid = -1; return; }
        int dev = 0, cus = 0, per_cu = 0;
        hipGetDevice(&dev); hipDeviceGetAttribute(&cus, hipDeviceAttributeMultiprocessorCount, dev);
        hipFuncSetAttribute((const void*)fwd_kernel, hipFuncAttributeMaxDynamicSharedMemorySize, LDS_BYTES);
        hipOccupancyMaxActiveBlocksPerMultiprocessor(&per_cu, (const void*)fwd_kernel, 512, LDS_BYTES);
        if (per_cu < 1) { fprintf(stderr, "kernel_launch: occupancy query says %d blocks/CU\n", per_cu); per_cu = 1; }
        if (per_cu > 1) per_cu = 1;
        grid = cus * per_cu;
    }
    if (grid < 0) return;
    Args a{};
    for (int i = 0; i < 20; ++i) a.in[i] = (const float*)d_in[i];
    a.out = (float*)d_out; a.ws = (unsigned char*)d_ws;
#if N_LAUNCH_MODE == 1
    a.ph_lo = 0; a.ph_hi = NPHASE; a.coop = 1;
    hipMemsetAsync((char*)d_ws + WS_BAR, 0, BAR_BYTES, stream);
    void* args[] = {&a};
    hipError_t e = hipLaunchCooperativeKernel((const void*)fwd_kernel, dim3(grid), dim3(512), args, LDS_BYTES, stream);
    if (e != hipSuccess) fprintf(stderr, "cooperative launch failed: %s (grid %d)\n", hipGetErrorString(e), grid);
#else
    for (int ph = 0; ph < NPHASE; ++ph) { a.ph_lo = ph; a.ph_hi = ph + 1; hipLaunchKernelGGL(fwd_kernel, dim3(grid), dim3(512), LDS_BYTES, stream, a); }
#endif
}
```

```cpp
#include <hip/hip_runtime.h>
#include <hip/hip_cooperative_groups.h>
#include <cstdio>
#include <cstdint>
namespace cg = cooperative_groups;
__device__ __forceinline__ int ltid() { int t = threadIdx.x; asm volatile("" : "+v"(t)); return t; }
namespace pg8 {
#define PG8_LAS __attribute__((address_space(3)))
typedef unsigned short bf16_t;
typedef short bf16x8 __attribute__((ext_vector_type(8)));
typedef float f32x4 __attribute__((ext_vector_type(4)));
typedef unsigned u32x4 __attribute__((ext_vector_type(4)));
constexpr int BM = 256, BK = 64, HALF = 128, HTB = HALF * BK * 2  , STAGE_BYTES = 8 * HTB, NXCD = 8, WGM = 8;

__host__ __device__ __forceinline__ int lds_byte(int r, int c) { const int st = (r >> 4) * 2 + (c >> 5), rr = r & 15, cc = c & 31, ob = rr * 64 + cc * 2; return st * 1024 + (ob ^ (((ob >> 9) & 1) << 5)); }
__host__ __device__ __forceinline__ void stage_rc(int b, int& R, int& C) { const int st = b / 1024, sb = b % 1024, swz = sb ^ (((sb >> 9) & 1) << 5); R = (st >> 1) * 16 + swz / 64; C = (st & 1) * 32 + (swz % 64) / 2; }
__host__ __device__ __forceinline__ int perm32(int rho) { const int n = rho >> 4, i = rho & 15; return 8 * (i >> 2) + 4 * n + (i & 3); }

struct Unit { int pm, pn; };
struct Gemm { const bf16_t* A; const bf16_t* Bt; int M, N, K; int a_rows = 256; };

struct StaticOrder {
    int nM, nN, nwg, G, c;
    __host__ __device__ void init(int M, int N, int G_, int c_) { nM = M / BM; nN = N / BM; nwg = nM * nN; G = G_; c = c_; }
    __host__ __device__ bool next(int i, Unit& u) const {
        const long L = (long)i * G + c; if (L >= nwg) return false;
        int wgid = (int)L; { const int q = nwg / NXCD, r = nwg % NXCD, xcd = wgid % NXCD, off = wgid / NXCD; wgid = (xcd < r ? xcd * (q + 1) : r * (q + 1) + (xcd - r) * q) + off; }
        const int nig = WGM * nN, gid = wgid / nig, fm = gid * WGM, gsz = (nM - fm) < WGM ? (nM - fm) : WGM;
        u.pm = fm + ((wgid % nig) % gsz); u.pn = (wgid % nig) / gsz; return true;
    }
    __device__ __forceinline__ void a_ready(const Unit&) const {}
    __device__ __forceinline__ void done(const Unit&) const {}
};

typedef float f32x2 __attribute__((ext_vector_type(2)));
__device__ __forceinline__ unsigned cvt_pk_bf16(float lo, float hi) { typedef __bf16 bf16x2_ __attribute__((ext_vector_type(2))); const f32x2 v = {lo, hi}; const bf16x2_ b = __builtin_convertvector(v, bf16x2_); return __builtin_bit_cast(unsigned, b); }
#ifndef WT_STORES
#define WT_STORES 0
#endif
#if WT_STORES
__device__ __forceinline__ void st16_wt(void* p, u32x4 v) { asm volatile("global_store_dwordx4 %0, %1, off sc0 sc1" :: "v"(p), "v"(v) : "memory"); }
#else
__device__ __forceinline__ void st16_wt(void* p, u32x4 v) { *(u32x4*)p = v; }
#endif
template <int ACT> struct EpiBf16 {
    static constexpr bool PERM = true, AFTER_DRAIN = false;
    bf16_t* O; int ldc;
    __device__ __forceinline__ void operator()(const f32x4 (&acc)[2][2][4][2], const Unit& u, int wr, int wc, int fr, int fq) const {
        const int row0 = u.pm * BM + wr * 64 + fr; const int col0 = u.pn * BM + wc * 32 + 8 * fq;
#pragma unroll
        for (int ai = 0; ai < 2; ++ai)
#pragma unroll
            for (int m = 0; m < 4; ++m) { bf16_t* rowp = O + (size_t)(row0 + ai * HALF + m * 16) * ldc + col0;
#pragma unroll
                for (int bj = 0; bj < 2; ++bj) { const f32x4 v0 = acc[ai][bj][m][0], v1 = acc[ai][bj][m][1];
                    u32x4 w; w.x = cvt_pk_bf16(v0[0], v0[1]); w.y = cvt_pk_bf16(v0[2], v0[3]); w.z = cvt_pk_bf16(v1[0], v1[1]); w.w = cvt_pk_bf16(v1[2], v1[3]);
                    st16_wt(rowp + bj * HALF, w); } }
    }
};
struct EpiInProj {
    static constexpr bool PERM = true, AFTER_DRAIN = false;
    bf16_t* P; float* G;
    __device__ __forceinline__ void operator()(const f32x4 (&acc)[2][2][4][2], const Unit& u, int wr, int wc, int fr, int fq) const {
        const int row0 = u.pm * BM + wr * 64 + fr; const int pn = u.pn;
        if (pn == 18) {
            if (wc == 0 && fq < 2) {
#pragma unroll
                for (int ai = 0; ai < 2; ++ai)
#pragma unroll
                    for (int m = 0; m < 4; ++m) { float* gp = G + (size_t)(row0 + ai * HALF + m * 16) * 16 + 8 * fq;
                        *(f32x4*)(gp) = acc[ai][0][m][0]; *(f32x4*)(gp + 4) = acc[ai][0][m][1]; }
            }
            return;
        }
        const int col0 = pn * BM + wc * 32 + 8 * fq;
        const int mode = (pn == 8 || pn == 9) ? 1 : (pn >= 14 ? 2 : 0);
#pragma unroll
        for (int ai = 0; ai < 2; ++ai)
#pragma unroll
            for (int m = 0; m < 4; ++m) { bf16_t* rowp = P + (size_t)(row0 + ai * HALF + m * 16) * 4608 + col0;
#pragma unroll
                for (int bj = 0; bj < 2; ++bj) { f32x4 v0 = acc[ai][bj][m][0], v1 = acc[ai][bj][m][1];
                    if (mode == 1) { v0 = v0 * 0.08838834764831845f; v1 = v1 * 0.08838834764831845f; }
                    else if (mode == 2) {
#pragma unroll
                        for (int j = 0; j < 4; ++j) { v0[j] = __builtin_amdgcn_rcpf(1.0f + __builtin_amdgcn_exp2f(-1.4426950408889634f * v0[j])); v1[j] = __builtin_amdgcn_rcpf(1.0f + __builtin_amdgcn_exp2f(-1.4426950408889634f * v1[j])); } }
                    u32x4 w; w.x = cvt_pk_bf16(v0[0], v0[1]); w.y = cvt_pk_bf16(v0[2], v0[3]); w.z = cvt_pk_bf16(v1[0], v1[1]); w.w = cvt_pk_bf16(v1[2], v1[3]);
                    *(u32x4*)(rowp + bj * HALF) = w; } }
    }
};
struct EpiResid {
    static constexpr bool PERM = false, AFTER_DRAIN = false;
    const float* base; float* out; const float* gate;
    __device__ __forceinline__ void operator()(const f32x4 (&acc)[2][2][4][2], const Unit& u, int wr, int wc, int fr, int fq) const {
        const int row0 = u.pm * BM + wr * 64 + fr; const int col0 = u.pn * BM + wc * 32 + 4 * fq;
#pragma unroll
        for (int bj = 0; bj < 2; ++bj)
#pragma unroll
            for (int n = 0; n < 2; ++n) { const f32x4 g = *(const f32x4*)(gate + col0 + bj * HALF + n * 16);
#pragma unroll
                for (int ai = 0; ai < 2; ++ai)
#pragma unroll
                    for (int m = 0; m < 4; ++m) { const size_t off = (size_t)(row0 + ai * HALF + m * 16) * 2048 + col0 + bj * HALF + n * 16;
                        const f32x4 b = *(const f32x4*)(base + off); { const f32x4 o_ = b + g * acc[ai][bj][m][n]; st16_wt(out + off, __builtin_bit_cast(u32x4, o_)); } } }
    }
};
struct RowStats {
    float* slots;
    unsigned* cnt;
    __device__ __forceinline__ void run(const f32x4 (&v)[2][2][4][2], const Unit& u, int wr, int wc, int fr, int fq, PG8_LAS unsigned char* lds, int wid, int lane) const {
        PG8_LAS float* Pp = (PG8_LAS float*)lds;
        PG8_LAS float* S = (PG8_LAS float*)(lds + 4096);
#pragma unroll
        for (int ai = 0; ai < 2; ++ai)
#pragma unroll
            for (int m = 0; m < 4; ++m) { float s = 0.f;
#pragma unroll
                for (int bj = 0; bj < 2; ++bj)
#pragma unroll
                    for (int n = 0; n < 2; ++n) { const f32x4 x = v[ai][bj][m][n]; s += (x[0] * x[0] + x[1] * x[1]) + (x[2] * x[2] + x[3] * x[3]); }
                s += __shfl_xor(s, 16); s += __shfl_xor(s, 32);
                if (fq == 0) Pp[(ai * HALF + wr * 64 + m * 16 + fr) * 4 + wc] = s; }
        asm volatile("s_waitcnt lgkmcnt(0)" ::: "memory"); __builtin_amdgcn_s_barrier(); asm volatile("" ::: "memory");
        const int row = wid * 32 + (lane & 31);
        if (lane < 32) { const float tot = (Pp[row * 4 + 0] + Pp[row * 4 + 1]) + (Pp[row * 4 + 2] + Pp[row * 4 + 3]);
            __hip_atomic_store(slots + (size_t)(u.pm * BM + row) * 8 + u.pn, tot, __ATOMIC_RELAXED, __HIP_MEMORY_SCOPE_AGENT); }
        asm volatile("s_waitcnt vmcnt(0)" ::: "memory");
        if (lane == 0) __hip_atomic_fetch_add(cnt + 64 * u.pm, 1u, __ATOMIC_RELAXED, __HIP_MEMORY_SCOPE_AGENT);
        if (wid == 0) { unsigned sp = 0;
            for (;;) { if ((unsigned)__builtin_amdgcn_readfirstlane(__hip_atomic_load(cnt + 64 * u.pm, __ATOMIC_RELAXED, __HIP_MEMORY_SCOPE_AGENT)) >= 64u) break;
                __builtin_amdgcn_s_sleep(2); if (++sp > (1u << 22)) break; }
            __builtin_amdgcn_fence(__ATOMIC_ACQUIRE, "agent"); }
        asm volatile("s_waitcnt vmcnt(0) lgkmcnt(0)" ::: "memory"); __builtin_amdgcn_s_barrier(); asm volatile("" ::: "memory");
        if (lane < 32) { const float* sl = slots + (size_t)(u.pm * BM + row) * 8; float q = 0.f;
#pragma unroll
            for (int t = 0; t < 8; ++t) q += __hip_atomic_load(sl + t, __ATOMIC_RELAXED, __HIP_MEMORY_SCOPE_AGENT);
            S[row] = rsqrtf(q * (1.0f / 2048.0f) + 1e-6f); }
        asm volatile("s_waitcnt lgkmcnt(0)" ::: "memory"); __builtin_amdgcn_s_barrier(); asm volatile("" ::: "memory");
    }
};
struct EpiResidNorm {
    static constexpr bool PERM = false, AFTER_DRAIN = true;
    const float* base; float* out; const float* gate; const float* gain; RowStats st;
    __device__ __forceinline__ void operator()(const f32x4 (&)[2][2][4][2], const Unit&, int, int, int, int) const {}
    __device__ __forceinline__ void fused(f32x4 (&acc)[2][2][4][2], const Unit& u, int wr, int wc, int fr, int fq, PG8_LAS unsigned char* lds, int wid, int lane) const {
        const int row0 = u.pm * BM + wr * 64 + fr; const int col0 = u.pn * BM + wc * 32 + 4 * fq; size_t off0 = (size_t)row0 * 2048 + col0;
#pragma unroll
        for (int bj = 0; bj < 2; ++bj)
#pragma unroll
            for (int n = 0; n < 2; ++n) { const f32x4 g = *(const f32x4*)(gate + col0 + bj * HALF + n * 16);
#pragma unroll
                for (int ai = 0; ai < 2; ++ai)
#pragma unroll
                    for (int m = 0; m < 4; ++m) { const size_t off = off0 + (size_t)((ai * HALF + m * 16) * 2048 + bj * HALF + n * 16);
                        acc[ai][bj][m][n] = __builtin_nontemporal_load((const f32x4*)(base + off)) + g * acc[ai][bj][m][n];
                        asm volatile("" : "+v"(acc[ai][bj][m][n]));
                        if (m == 3) asm volatile("" ::: "memory"); } }
        st.run(acc, u, wr, wc, fr, fq, lds, wid, lane);
        asm volatile("" : "+v"(off0));
        const PG8_LAS float* S = (const PG8_LAS float*)(lds + 4096);
#pragma unroll
        for (int bj = 0; bj < 2; ++bj)
#pragma unroll
            for (int n = 0; n < 2; ++n) { const f32x4 gn = *(const f32x4*)(gain + col0 + bj * HALF + n * 16);
#pragma unroll
                for (int ai = 0; ai < 2; ++ai)
#pragma unroll
                    for (int m = 0; m < 4; ++m) { const int r = ai * HALF + wr * 64 + m * 16 + fr; const size_t off = off0 + (size_t)((ai * HALF + m * 16) * 2048 + bj * HALF + n * 16);
                        { const f32x4 o_ = acc[ai][bj][m][n] * S[r] * gn; __builtin_nontemporal_store(o_, (f32x4*)(out + off)); } }
                asm volatile("" ::: "memory"); }
    }
};
struct EpiResidNormMod {
    static constexpr bool PERM = false, AFTER_DRAIN = true;
    const float* base; float* out; const float* gate; const float* gain; const float* sh; const float* sc; bf16_t* hn; RowStats st;
    __device__ __forceinline__ void operator()(const f32x4 (&)[2][2][4][2], const Unit&, int, int, int, int) const {}
    __device__ __forceinline__ void fused(f32x4 (&acc)[2][2][4][2], const Unit& u, int wr, int wc, int fr, int fq, PG8_LAS unsigned char* lds, int wid, int lane) const {
        typedef unsigned u32x2_ __attribute__((ext_vector_type(2)));
        const int row0 = u.pm * BM + wr * 64 + fr; const int col0 = u.pn * BM + wc * 32 + 4 * fq; size_t off0 = (size_t)row0 * 2048 + col0;
#pragma unroll
        for (int bj = 0; bj < 2; ++bj)
#pragma unroll
            for (int n = 0; n < 2; ++n) { const f32x4 g = *(const f32x4*)(gate + col0 + bj * HALF + n * 16);
#pragma unroll
                for (int ai = 0; ai < 2; ++ai)
#pragma unroll
                    for (int m = 0; m < 4; ++m) { const size_t off = off0 + (size_t)((ai * HALF + m * 16) * 2048 + bj * HALF + n * 16);
                        const f32x4 x1 = __builtin_nontemporal_load((const f32x4*)(base + off)) + g * acc[ai][bj][m][n]; acc[ai][bj][m][n] = x1; __builtin_nontemporal_store(x1, (f32x4*)(out + off));
                        asm volatile("" : "+v"(acc[ai][bj][m][n]));
                        if (m == 3) asm volatile("" ::: "memory"); } }
        st.run(acc, u, wr, wc, fr, fq, lds, wid, lane);
        asm volatile("" : "+v"(off0));
        const PG8_LAS float* S = (const PG8_LAS float*)(lds + 4096);
#pragma unroll
        for (int bj = 0; bj < 2; ++bj)
#pragma unroll
            for (int n = 0; n < 2; ++n) { const int c = col0 + bj * HALF + n * 16; const f32x4 gn = *(const f32x4*)(gain + c), s1 = *(const f32x4*)(sc + c) + 1.0f, s0 = *(const f32x4*)(sh + c);
#pragma unroll
                for (int ai = 0; ai < 2; ++ai)
#pragma unroll
                    for (int m = 0; m < 4; ++m) { const int r = ai * HALF + wr * 64 + m * 16 + fr; const size_t off = off0 + (size_t)((ai * HALF + m * 16) * 2048 + bj * HALF + n * 16);
                        const f32x4 y = (acc[ai][bj][m][n] * S[r] * gn) * s1 + s0; u32x2_ w; w.x = cvt_pk_bf16(y[0], y[1]); w.y = cvt_pk_bf16(y[2], y[3]); *(u32x2_*)(hn + off) = w; }
                asm volatile("" ::: "memory"); }
    }
};
template <class Epi, class Sched, bool ALIGN_EPI = false, bool SP2 = false>
__device__ __forceinline__ void gemm_phase(PG8_LAS unsigned char* lds, const Gemm g, const Sched& S, const Epi& E) {
    const int tid = ltid(), wid = __builtin_amdgcn_readfirstlane(tid >> 6), lane = tid & 63, wr = wid >> 2, wc = wid & 3, fr = lane & 15, fq = lane >> 4;
    const int K = g.K, nt = K / BK;
    unsigned voffA[2], voffB[2];
#pragma unroll
    for (int i = 0; i < 2; ++i) { int R, C; stage_rc(tid * 16 + i * 8192, R, C); const int Rb = Epi::PERM ? ((R & ~31) + perm32(R & 31)) : R;
        voffA[i] = (unsigned)(R * K + C) * 2u; voffB[i] = (unsigned)(Rb * K + C) * 2u; }
    const size_t kstep = (size_t)(BK * 2);
    const size_t hstep = (size_t)HALF * K * 2;
    const size_t tstep = 2 * hstep; const size_t tstepA = (size_t)g.a_rows * K * 2;
    const unsigned ldsw = (unsigned)wid * 1024u;
    const int aoff = lds_byte(wr * 64 + fr, fq * 8), boff = lds_byte(wc * 32 + fr, fq * 8);
#define PG8_SA(b, h) (((b) * 2 + (h)) * HTB)
#define PG8_SB(b, h) ((4 + (b) * 2 + (h)) * HTB)
#define PG8_STAGE(bufoff, gbase, voff) do { _Pragma("unroll") for (int _i = 0; _i < 2; ++_i) \
        __builtin_amdgcn_global_load_lds((const unsigned*)((const char*)(gbase) + (voff)[_i]), (PG8_LAS unsigned*)(lds + (bufoff) + ldsw + _i * 8192), 16, 0, 0); } while (0)
#define PG8_LDA(dst, b, h) do { _Pragma("unroll") for (int m = 0; m < 4; ++m) _Pragma("unroll") for (int k = 0; k < 2; ++k) dst[m][k] = *(const PG8_LAS bf16x8*)(lds + PG8_SA(b, h) + aoff + m * 2048 + k * 1024); } while (0)
#define PG8_LDB(dst, b, h) do { _Pragma("unroll") for (int n = 0; n < 2; ++n) _Pragma("unroll") for (int k = 0; k < 2; ++k) dst[n][k] = *(const PG8_LAS bf16x8*)(lds + PG8_SB(b, h) + boff + n * 2048 + k * 1024); } while (0)
#define PG8_MMA(ai, bj, At, Bt) do { __builtin_amdgcn_s_setprio(1); _Pragma("unroll") for (int m = 0; m < 4; ++m) _Pragma("unroll") for (int n = 0; n < 2; ++n) _Pragma("unroll") for (int k = 0; k < 2; ++k) \
        acc[ai][bj][m][n] = __builtin_amdgcn_mfma_f32_16x16x32_bf16(Bt[n][k], At[m][k], acc[ai][bj][m][n], 0, 0, 0); __builtin_amdgcn_s_setprio(0); } while (0)
#define PG8_WAIT_V(n) asm volatile("s_waitcnt vmcnt(" #n ")" ::: "memory")
#define PG8_WAIT_L(n) asm volatile("s_waitcnt lgkmcnt(" #n ")" ::: "memory")
#define PG8_BAR __builtin_amdgcn_s_barrier()
#define PG8_SCHED __builtin_amdgcn_sched_barrier(0)
    Unit cur, nxt; int ui = 0;
    if (!S.next(0, cur)) return;
    f32x4 acc[2][2][4][2];
#pragma unroll
    for (int a = 0; a < 2; ++a)
#pragma unroll
        for (int b = 0; b < 2; ++b)
#pragma unroll
            for (int m = 0; m < 4; ++m)
#pragma unroll
                for (int n = 0; n < 2; ++n) acc[a][b][m][n] = (f32x4){0.f, 0.f, 0.f, 0.f};
    bf16x8 At[4][2], B0[2][2], B1[2][2];
    const char* cA = (const char*)g.A + (size_t)cur.pm * tstepA; const char* cB = (const char*)g.Bt + (size_t)cur.pn * tstep;
    S.a_ready(cur);
    if constexpr (SP2) {
        PG8_STAGE(PG8_SB(0, 0), cB, voffB); PG8_STAGE(PG8_SB(0, 1), cB + hstep, voffB); PG8_STAGE(PG8_SA(0, 0), cA, voffA); PG8_STAGE(PG8_SA(0, 1), cA + hstep, voffA);
        if (wr == 1) PG8_BAR;
        PG8_WAIT_V(2); PG8_BAR;
        PG8_STAGE(PG8_SB(1, 0), cB + kstep, voffB); PG8_STAGE(PG8_SA(1, 0), cA + kstep, voffA); PG8_STAGE(PG8_SB(1, 1), cB + hstep + kstep, voffB);
        PG8_WAIT_V(6); PG8_BAR;
    } else {
        PG8_STAGE(PG8_SB(0, 0), cB, voffB); PG8_STAGE(PG8_SA(0, 0), cA, voffA); PG8_STAGE(PG8_SB(0, 1), cB + hstep, voffB); PG8_STAGE(PG8_SA(0, 1), cA + hstep, voffA);
        if (wr == 1) PG8_BAR;
        PG8_WAIT_V(4); PG8_BAR;
        PG8_STAGE(PG8_SB(1, 0), cB + kstep, voffB); PG8_STAGE(PG8_SA(1, 0), cA + kstep, voffA); PG8_STAGE(PG8_SB(1, 1), cB + hstep + kstep, voffB);
        PG8_WAIT_V(6); PG8_BAR;
    }
    for (;;) {
        const bool has_next = S.next(ui + 1, nxt);
        const char* nA = has_next ? (const char*)g.A + (size_t)nxt.pm * tstepA : cA; const char* nB = has_next ? (const char*)g.Bt + (size_t)nxt.pn * tstep : cB;
        for (int t = 0; t < nt; t += 2) {
            const bool last = (t == nt - 2);
            const char* a1 = cA + (size_t)(t + 1) * kstep;
            const char* a2 = last ? nA : cA + (size_t)(t + 2) * kstep; const char* b2 = last ? nB : cB + (size_t)(t + 2) * kstep;
            const char* a3 = a2 + kstep; const char* b3 = b2 + kstep;
            if (last && has_next) S.a_ready(nxt);
            if constexpr (SP2) {
            PG8_LDB(B0, 0, 0); PG8_LDB(B1, 0, 1); PG8_SCHED; PG8_LDA(At, 0, 0); PG8_STAGE(PG8_SA(1, 1), a1 + hstep, voffA);
            PG8_WAIT_V(8); PG8_WAIT_L(0); PG8_BAR; PG8_MMA(0, 0, At, B0); PG8_MMA(0, 1, At, B1); PG8_BAR; PG8_SCHED;
            PG8_LDA(At, 0, 1); PG8_STAGE(PG8_SB(0, 0), b2, voffB); PG8_STAGE(PG8_SB(0, 1), b2 + hstep, voffB); PG8_STAGE(PG8_SA(0, 0), a2, voffA);
            PG8_WAIT_V(8); PG8_WAIT_L(0); PG8_BAR; PG8_MMA(1, 0, At, B0); PG8_MMA(1, 1, At, B1); PG8_BAR; PG8_SCHED;
            PG8_LDB(B0, 1, 0); PG8_LDB(B1, 1, 1); PG8_SCHED; PG8_LDA(At, 1, 0); PG8_STAGE(PG8_SA(0, 1), a2 + hstep, voffA);
            PG8_WAIT_V(8); PG8_WAIT_L(0); PG8_BAR; PG8_MMA(0, 0, At, B0); PG8_MMA(0, 1, At, B1); PG8_BAR; PG8_SCHED;
            PG8_LDA(At, 1, 1); PG8_STAGE(PG8_SB(1, 0), b3, voffB); PG8_STAGE(PG8_SB(1, 1), b3 + hstep, voffB); PG8_STAGE(PG8_SA(1, 0), a3, voffA);
            PG8_WAIT_V(8); PG8_WAIT_L(0); PG8_BAR; PG8_MMA(1, 0, At, B0); PG8_MMA(1, 1, At, B1); PG8_BAR; PG8_SCHED;
            } else {
            PG8_LDB(B0, 0, 0); PG8_SCHED; PG8_LDA(At, 0, 0); PG8_STAGE(PG8_SA(1, 1), a1 + hstep, voffA);
            PG8_WAIT_L(8); PG8_BAR; PG8_WAIT_L(0); PG8_MMA(0, 0, At, B0); PG8_BAR; PG8_SCHED;
            PG8_LDB(B1, 0, 1); PG8_STAGE(PG8_SB(0, 0), b2, voffB);
            PG8_BAR; PG8_WAIT_L(0); PG8_MMA(0, 1, At, B1); PG8_BAR;
            PG8_LDA(At, 0, 1); PG8_STAGE(PG8_SA(0, 0), a2, voffA);
            PG8_BAR; PG8_WAIT_L(0); PG8_MMA(1, 0, At, B0); PG8_BAR; PG8_SCHED;
            PG8_STAGE(PG8_SB(0, 1), b2 + hstep, voffB);
            PG8_WAIT_V(6); PG8_BAR; PG8_MMA(1, 1, At, B1); PG8_BAR;
            PG8_LDB(B0, 1, 0); PG8_SCHED; PG8_LDA(At, 1, 0); PG8_STAGE(PG8_SA(0, 1), a2 + hstep, voffA);
            PG8_WAIT_L(8); PG8_BAR; PG8_WAIT_L(0); PG8_MMA(0, 0, At, B0); PG8_BAR; PG8_SCHED;
            PG8_LDB(B1, 1, 1); PG8_STAGE(PG8_SB(1, 0), b3, voffB);
            PG8_BAR; PG8_WAIT_L(0); PG8_MMA(0, 1, At, B1); PG8_BAR;
            PG8_LDA(At, 1, 1); PG8_STAGE(PG8_SA(1, 0), a3, voffA);
            PG8_BAR; PG8_WAIT_L(0); PG8_MMA(1, 0, At, B0); PG8_BAR; PG8_SCHED;
            PG8_STAGE(PG8_SB(1, 1), b3 + hstep, voffB);
            PG8_WAIT_V(6); PG8_BAR; PG8_MMA(1, 1, At, B1); PG8_BAR;
            }
        }
        if constexpr (ALIGN_EPI) { if (wr == 0) PG8_BAR; }
        if constexpr (!Epi::AFTER_DRAIN) { E(acc, cur, wr, wc, fr, fq); S.done(cur); }
        if (!has_next) break;
#pragma unroll
        for (int a = 0; a < 2; ++a)
#pragma unroll
            for (int b = 0; b < 2; ++b)
#pragma unroll
                for (int m = 0; m < 4; ++m)
#pragma unroll
                    for (int n = 0; n < 2; ++n) acc[a][b][m][n] = (f32x4){0.f, 0.f, 0.f, 0.f};
        cur = nxt; cA = nA; cB = nB; ++ui;
        if constexpr (ALIGN_EPI) { if (wr == 1) PG8_BAR; }
    }
    PG8_WAIT_V(0);
    if constexpr (!ALIGN_EPI) { if (wr == 0) PG8_BAR; }
    PG8_BAR;
    if constexpr (Epi::AFTER_DRAIN) { E.fused(acc, cur, wr, wc, fr, fq, lds, wid, lane); S.done(cur); }
#undef PG8_SA
#undef PG8_SB
#undef PG8_STAGE
#undef PG8_LDA
#undef PG8_LDB
#undef PG8_MMA
#undef PG8_WAIT_V
#undef PG8_WAIT_L
#undef PG8_BAR
#undef PG8_SCHED
}
}
namespace att {
typedef unsigned short bf16;
constexpr int   D = 128, NW = 8, QBLK = 32, KVBLK = 64;
constexpr float SCALE = 0.088388347648318440f;
constexpr float THR = 8.f;
constexpr int LDQ = 4608, LDK = 4608, LDO = 2048;
constexpr size_t SHM_V = KVBLK * D * 2, SHM_K = KVBLK * D * 2, SHM_ATTN = 2 * SHM_V + 2 * SHM_K + NW * 64 * 4;
using bf16x8 = __attribute__((ext_vector_type(8))) short;
using s16x4  = __attribute__((ext_vector_type(4))) short;
using f32x16 = __attribute__((ext_vector_type(16))) float;
using u32x4  = __attribute__((ext_vector_type(4))) unsigned;
#define KSWZ(row, colB) ((row) * 256 + ((colB) ^ (((row) & 7) << 4)))
#define SBAR() __builtin_amdgcn_sched_barrier(0)
__device__ __forceinline__ int crow(int r, int hi) { return (r & 3) + 8 * (r >> 2) + 4 * hi; }
__device__ __forceinline__ unsigned cvtpk(float lo, float hi) {
  unsigned r; asm volatile("v_cvt_pk_bf16_f32 %0, %1, %2" : "=v"(r) : "v"(lo), "v"(hi)); return r;
}
__device__ __forceinline__ bf16x8 ld8(const bf16* p) { return *reinterpret_cast<const bf16x8*>(p); }
__device__ __forceinline__ void partialSM(f32x16& p0, f32x16& p1, float& m_reg, float& mn, float& alpha) {
  constexpr float C = SCALE * 1.4426950408889634f;
  float pmax = p0[0]; for (int r = 1; r < 16; ++r) pmax = fmaxf(pmax, p0[r]); for (int r = 0; r < 16; ++r) pmax = fmaxf(pmax, p1[r]);
  { auto rr = __builtin_amdgcn_permlane32_swap(__float_as_uint(pmax), __float_as_uint(pmax), false, false);
    pmax = fmaxf(__uint_as_float(rr[0]), __uint_as_float(rr[1])); }
  if (__builtin_expect(__all(pmax - m_reg <= THR / SCALE), 1)) { mn = m_reg; alpha = 1.f; }
  else { mn = fmaxf(m_reg, pmax); alpha = __builtin_amdgcn_exp2f((m_reg - mn) * C); m_reg = mn; }
  float mnC = -mn * C;
  for (int r = 0; r < 16; ++r) p0[r] = fmaf(p0[r], C, mnC); for (int r = 0; r < 16; ++r) p1[r] = fmaf(p1[r], C, mnC);
  for (int r = 0; r < 16; ++r) p0[r] = __builtin_amdgcn_exp2f(p0[r]);
}
#define PK4(P, BASE, OUT) do { unsigned a0 = cvtpk(P[BASE + 0], P[BASE + 1]), a1 = cvtpk(P[BASE + 2], P[BASE + 3]);   \
    unsigned b0 = cvtpk(P[BASE + 4], P[BASE + 5]), b1 = cvtpk(P[BASE + 6], P[BASE + 7]);                              \
    auto r0 = __builtin_amdgcn_permlane32_swap(a0, b0, false, false); auto r1 = __builtin_amdgcn_permlane32_swap(a1, b1, false, false); \
    u32x4 w = {r0[0], r1[0], r0[1], r1[1]}; OUT = *reinterpret_cast<bf16x8*>(&w); } while (0)
__device__ __forceinline__ void finishSM(f32x16& p0, f32x16& p1, float alpha, float& l_reg, bf16x8& pa0, bf16x8& pa1, bf16x8& pa2, bf16x8& pa3) {
  for (int r = 0; r < 16; ++r) p1[r] = __builtin_amdgcn_exp2f(p1[r]);
  float ps = 0; for (int r = 0; r < 16; ++r) ps += p0[r]; for (int r = 0; r < 16; ++r) ps += p1[r];
  { auto rr = __builtin_amdgcn_permlane32_swap(__float_as_uint(ps), __float_as_uint(ps), false, false);
    ps = __uint_as_float(rr[0]) + __uint_as_float(rr[1]); }
  l_reg = l_reg * alpha + ps;
  PK4(p0, 0, pa0); PK4(p0, 8, pa1); PK4(p1, 0, pa2); PK4(p1, 8, pa3);
}
__device__ __forceinline__ void qkt(f32x16& p0, f32x16& p1, const bf16* Ks, const bf16x8* qr, int r32, int hi) {
  p0 = f32x16{}; p1 = f32x16{};
  for (int d0 = 0; d0 < 8; ++d0) { int cb = (d0 * 16 + hi * 8) * 2;
    bf16x8 b0 = *reinterpret_cast<const bf16x8*>((const char*)Ks + KSWZ(r32, cb));
    bf16x8 b1 = *reinterpret_cast<const bf16x8*>((const char*)Ks + KSWZ(32 + r32, cb));
    p0 = __builtin_amdgcn_mfma_f32_32x32x16_bf16(b0, qr[d0], p0, 0, 0, 0);
    p1 = __builtin_amdgcn_mfma_f32_32x32x16_bf16(b1, qr[d0], p1, 0, 0, 0); }
}
__device__ __forceinline__ int v_st(int k, int c) { const int kk = (k & ~0xC) | ((k & 4) << 1) | ((k & 8) >> 1); return ((kk >> 3) * 4 + (c >> 5)) * 512 + ((kk & 7) * 32 + (c & 31)) * 2; }
__device__ __forceinline__ int v_rd_base(int lane) { return ((lane & 3) << 3) | (((lane >> 2) & 3) << 6) | (((lane >> 4) & 1) << 5) | (((lane >> 5) & 1) << 8); }
constexpr int v_rd_off(int d0, int ks, int half) { return d0 * 512 + ks * 4096 + half * 2048; }
template <int OFF> __device__ __forceinline__ s16x4 tr_read(int vb) {
  s16x4 r; asm volatile("ds_read_b64_tr_b16 %0, %1 offset:%2" : "=&v"(r) : "v"(vb), "i"(OFF) : "memory"); return r;
}
template <int D0> __device__ __forceinline__ void pv_one(f32x16& od, int vb, bf16x8 pa0, bf16x8 pa1, bf16x8 pa2, bf16x8 pa3) {
  const s16x4 l0 = tr_read<v_rd_off(D0, 0, 0)>(vb), h0 = tr_read<v_rd_off(D0, 0, 1)>(vb), l1 = tr_read<v_rd_off(D0, 1, 0)>(vb), h1 = tr_read<v_rd_off(D0, 1, 1)>(vb);
  const s16x4 l2 = tr_read<v_rd_off(D0, 2, 0)>(vb), h2 = tr_read<v_rd_off(D0, 2, 1)>(vb), l3 = tr_read<v_rd_off(D0, 3, 0)>(vb), h3 = tr_read<v_rd_off(D0, 3, 1)>(vb);
  asm volatile("s_waitcnt lgkmcnt(0)" ::: "memory"); SBAR();
#define PK(L, H) (bf16x8){L[0], L[1], L[2], L[3], H[0], H[1], H[2], H[3]}
  od = __builtin_amdgcn_mfma_f32_32x32x16_bf16(pa0, PK(l0, h0), od, 0, 0, 0);
  od = __builtin_amdgcn_mfma_f32_32x32x16_bf16(pa1, PK(l1, h1), od, 0, 0, 0);
  od = __builtin_amdgcn_mfma_f32_32x32x16_bf16(pa2, PK(l2, h2), od, 0, 0, 0);
  od = __builtin_amdgcn_mfma_f32_32x32x16_bf16(pa3, PK(l3, h3), od, 0, 0, 0);
#undef PK
}
__device__ __forceinline__ void pv_d0(f32x16* o, int vb, bf16x8 pa0, bf16x8 pa1, bf16x8 pa2, bf16x8 pa3) {
  pv_one<0>(o[0], vb, pa0, pa1, pa2, pa3); pv_one<1>(o[1], vb, pa0, pa1, pa2, pa3); pv_one<2>(o[2], vb, pa0, pa1, pa2, pa3); pv_one<3>(o[3], vb, pa0, pa1, pa2, pa3);
}
__device__ __forceinline__ void attn_dense_body(const bf16* __restrict__ Qb, const bf16* __restrict__ Kh, const bf16* __restrict__ Vh,
                                                bf16* __restrict__ Ob, int seq, char* lds) {
  const int tid = ltid(), wid = tid >> 6, lane = tid & 63, r32 = lane & 31, hi = lane >> 5;
  bf16* V_lds = (bf16*)lds; bf16* K_lds = (bf16*)(lds + 2 * SHM_V);
  float* ws = (float*)(lds + 2 * SHM_V + 2 * SHM_K) + wid * 64; float* li_l = ws; float* al_l = ws + 32;
  float m_reg = -1e30f, l_reg = 0; f32x16 o[4] = {}; bf16x8 qr[8];
  const bf16* Qw = Qb + (long)(wid * QBLK + r32) * LDQ + hi * 8;
#pragma unroll
  for (int d0 = 0; d0 < 8; ++d0) qr[d0] = ld8(Qw + d0 * 16);
  const int sr = tid >> 4, sc = (tid & 15) * 8, vst0 = v_st(sr, sc), vst1 = v_st(32 + sr, sc);
  const int vb0 = (int)(uintptr_t)V_lds + v_rd_base(lane);
  struct { bf16x8 vs0, vs1, ks0, ks1; } sr_[1];
#define SLOAD(i, k0) do { sr_[i].vs0 = ld8(&Vh[(long)((k0) + sr) * LDK + sc]); sr_[i].vs1 = ld8(&Vh[(long)((k0) + 32 + sr) * LDK + sc]); \
    sr_[i].ks0 = ld8(&Kh[(long)((k0) + sr) * LDK + sc]); sr_[i].ks1 = ld8(&Kh[(long)((k0) + 32 + sr) * LDK + sc]); } while (0)
#define SWRITE(b, i) do { *(bf16x8*)((char*)V_lds + (b) * SHM_V + vst0) = sr_[i].vs0;          \
    *(bf16x8*)((char*)V_lds + (b) * SHM_V + vst1) = sr_[i].vs1; int kc = sc * 2;               \
    *(bf16x8*)((char*)K_lds + (b) * SHM_K + KSWZ(sr, kc)) = sr_[i].ks0;                       \
    *(bf16x8*)((char*)K_lds + (b) * SHM_K + KSWZ(32 + sr, kc)) = sr_[i].ks1; } while (0)
#define SWAIT() do { asm volatile("s_waitcnt vmcnt(0)" ::: "memory"); } while (0)
#define RESC(a) do { if (__any((a) < 1.f)) { if (hi == 0) al_l[r32] = (a); asm volatile("s_waitcnt lgkmcnt(0)" ::: "memory"); \
    for (int d = 0; d < 4; ++d) for (int r = 0; r < 16; ++r) o[d][r] *= al_l[crow(r, hi)]; } } while (0)
  f32x16 pA0, pA1, pB0, pB1; float mnA, mnB, alA, alB; bf16x8 pa0, pa1, pa2, pa3; const int NT = seq / KVBLK;
  constexpr int SE = 0, SO = 0;
  SLOAD(SE, 0); asm volatile("s_waitcnt vmcnt(0)" ::: "memory"); SWRITE(0, SE); __syncthreads();
  qkt(pA0, pA1, K_lds, qr, r32, hi); partialSM(pA0, pA1, m_reg, mnA, alA);
  SLOAD(SO, KVBLK);
  SWAIT(); SWRITE(1, SO); __syncthreads();
  for (int j = 1; j + 1 < NT; j += 2) {
    SBAR(); qkt(pB0, pB1, (bf16*)((char*)K_lds + SHM_K), qr, r32, hi);
    finishSM(pA0, pA1, alA, l_reg, pa0, pa1, pa2, pa3); SBAR();
    SLOAD(SO, (j + 1) * KVBLK); SBAR();
    pv_d0(o, vb0, pa0, pa1, pa2, pa3); partialSM(pB0, pB1, m_reg, mnB, alB);
    __syncthreads(); SWAIT(); SWRITE(0, SE);
    RESC(alB); __syncthreads();
    SBAR(); qkt(pA0, pA1, K_lds, qr, r32, hi);
    finishSM(pB0, pB1, alB, l_reg, pa0, pa1, pa2, pa3); SBAR();
    SLOAD(SE, (j + 2) * KVBLK); SBAR();
    pv_d0(o, vb0 + (int)SHM_V, pa0, pa1, pa2, pa3); partialSM(pA0, pA1, m_reg, mnA, alA);
    __syncthreads(); SWAIT(); SWRITE(1, SO);
    RESC(alA); __syncthreads();
  }
  SBAR(); qkt(pB0, pB1, (bf16*)((char*)K_lds + SHM_K), qr, r32, hi);
  finishSM(pA0, pA1, alA, l_reg, pa0, pa1, pa2, pa3); SBAR();
  pv_d0(o, vb0, pa0, pa1, pa2, pa3); partialSM(pB0, pB1, m_reg, mnB, alB);
  __syncthreads(); RESC(alB);
  finishSM(pB0, pB1, alB, l_reg, pa0, pa1, pa2, pa3); SBAR();
  pv_d0(o, vb0 + (int)SHM_V, pa0, pa1, pa2, pa3);
  if (hi == 0) li_l[r32] = l_reg; asm volatile("s_waitcnt lgkmcnt(0)" ::: "memory");
  float rli[16];
#pragma unroll
  for (int r = 0; r < 16; ++r) rli[r] = __builtin_amdgcn_rcpf(li_l[crow(r, hi)]);
  bf16* Ow = Ob + (long)(wid * QBLK) * LDO;
#pragma unroll
  for (int r = 0; r < 16; ++r) { int orow = crow(r, hi);
    for (int d0 = 0; d0 < 4; ++d0) { const float v = o[d0][r] * rli[r]; Ow[(long)orow * LDO + d0 * 32 + r32] = (bf16)(cvtpk(v, v) & 0xffffu); } }
#undef SLOAD
#undef SWRITE
#undef SWAIT
#undef RESC
}
}
#define LAS __attribute__((address_space(3)))
#define XB_TMO      128
#define XB_XCNT(j)  (256  + 64 * (j))
#define XB_XSUB(j)  (1280 + 64 * (j))
#define XB_XGEN(j)  (2304 + 64 * (j))
#define XB_TOP      3328
#define XB_TOPGEN   3392
#define XCD_BAR_WORDS 3456
#define XB_SPIN_CAP (1u << 18)

__device__ __forceinline__ unsigned xb_ld(unsigned* p)              { return __hip_atomic_load(p, __ATOMIC_RELAXED, __HIP_MEMORY_SCOPE_AGENT); }
__device__ __forceinline__ unsigned xb_add(unsigned* p, unsigned v) { return __hip_atomic_fetch_add(p, v, __ATOMIC_RELAXED, __HIP_MEMORY_SCOPE_AGENT); }
__device__ __forceinline__ unsigned xb_xcc_id() { return (unsigned)__builtin_amdgcn_s_getreg((3 << 11) | 20) & 0xFu; }
#define XB_SPIN(cond, bar) do { unsigned _sp = 0; while (cond) { __builtin_amdgcn_s_sleep(1); \
    if ((++_sp & 255u) == 0u) { if (xb_ld(&(bar)[XB_TMO])) break; if (_sp > XB_SPIN_CAP) { atomicAdd(&(bar)[XB_TMO], 1u); break; } } } } while (0)

struct XcdBarrier {
    unsigned* bar; unsigned x;
    volatile LAS unsigned* st;
};

__device__ __forceinline__ XcdBarrier xcd_barrier_post(unsigned* bar, volatile LAS unsigned* st) {
    XcdBarrier b; b.bar = bar; b.x = xb_xcc_id(); b.st = st;
    if (threadIdx.x == 0) (void)xb_add(&bar[XB_XCNT(b.x)], 1u);
    return b;
}
__device__ __forceinline__ void xcd_barrier_complete(unsigned* bar, unsigned x, unsigned& nloc, unsigned& nx) {
    const unsigned G = gridDim.x * gridDim.y * gridDim.z;
    unsigned sum, cnt, mine, sp = 0u;
    for (;;) {
        sum = 0u; cnt = 0u; mine = 0u;
#pragma unroll
        for (unsigned j = 0; j < 16; ++j) { const unsigned c = xb_ld(&bar[XB_XCNT(j)]); sum += c; cnt += (c > 0u) ? 1u : 0u; mine = (j == x) ? c : mine; }
        if (sum == G) break;
        __builtin_amdgcn_s_sleep(1);
        if ((++sp & 255u) == 0u) { if (xb_ld(&bar[XB_TMO])) break; if (sp > XB_SPIN_CAP) { atomicAdd(&bar[XB_TMO], 1u); break; } }
    }
    nloc = mine > 0u ? mine : 1u; nx = cnt > 0u ? cnt : 1u;
}

__device__ __forceinline__ void xcd_barrier(const XcdBarrier& b) {
    asm volatile("s_waitcnt vmcnt(0)" ::: "memory");
    __syncthreads();
    if (threadIdx.x == 0) {
        unsigned* bar = b.bar;
        __builtin_amdgcn_s_waitcnt(0);
        unsigned nloc = b.st[0], nx = b.st[1];
        if (nloc == 0u) { xcd_barrier_complete(bar, b.x, nloc, nx); b.st[0] = nloc; b.st[1] = nx; }
        const unsigned old = xb_add(&bar[XB_XSUB(b.x)], 1u);
        const unsigned gen = old / nloc;
        if (old + 1u == (gen + 1u) * nloc) {
            __builtin_amdgcn_fence(__ATOMIC_RELEASE, "agent");
            asm volatile("s_waitcnt vmcnt(0)" ::: "memory");
            const unsigned og = xb_add(&bar[XB_TOP], 1u);
            const unsigned tg = og / nx;
            if (og + 1u == (tg + 1u) * nx) xb_add(&bar[XB_TOPGEN], 1u);
            else XB_SPIN(xb_ld(&bar[XB_TOPGEN]) == tg, bar);
            __builtin_amdgcn_fence(__ATOMIC_ACQUIRE, "agent");
            xb_add(&bar[XB_XGEN(b.x)], 1u);
            asm volatile("s_waitcnt vmcnt(0)" ::: "memory");
        } else {
            XB_SPIN(xb_ld(&bar[XB_XGEN(b.x)]) == gen, bar);
            __builtin_amdgcn_fence(__ATOMIC_ACQUIRE, "agent");
            asm volatile("s_waitcnt vmcnt(0)" ::: "memory");
        }
    }
    __syncthreads();
}
typedef unsigned short bf16_t;
typedef float f32x4 __attribute__((ext_vector_type(4)));
typedef unsigned u32x4 __attribute__((ext_vector_type(4)));
typedef unsigned u32x2 __attribute__((ext_vector_type(2)));
using att::bf16x8; using att::s16x4; using att::f32x16; using att::crow; using att::cvtpk;

constexpr int DM = 2048, SEQ = 8192, CTXL = 256, MROWS = SEQ + CTXL  , NPROJ = 4608, NPROJ_PAD = 4864, INPROJ = 4624, DFF = 5632, NUP = 2 * DFF;
constexpr int OFF_AQ = 0, OFF_AK = 1024, OFF_AV = 1280, OFF_MQ = 1536, OFF_MK = 2048, OFF_MV = 2560, OFF_MO = 3584;
constexpr float EPS = 1e-6f;
constexpr int NSTEP = 132, SROWS = 257; constexpr size_t ST_BLK = (size_t)SROWS * 128;
constexpr size_t MiB = 1u << 20;
constexpr size_t WS_MODX = 0, WS_MODC = 64 * 1024, WS_BL = 128 * 1024, WS_G = 256 * 1024, WS_BAR = 1 * MiB, BAR_BYTES = 65536, WS_CNT1 = 1 * MiB + 16384, WS_CNT2 = 1 * MiB + 32768, WS_SLOT1 = 1 * MiB + 256 * 1024, WS_SLOT2 = 1 * MiB + 512 * 1024;
constexpr size_t WS_WDOWN = 2 * MiB, WS_WIN = 24 * MiB, WS_WOUT = 43 * MiB, WS_WUP = 51 * MiB, WS_H = 95 * MiB, WS_MIX = 128 * MiB, WS_ACT = 24 * MiB;
constexpr size_t WS_P = 160 * MiB, WS_ST = 235 * MiB, WS_U = 160 * MiB, WS_TILE = 256 * MiB, WS_END = 368 * MiB;
constexpr int LDS_BYTES = 131072 + 1024;
constexpr int NPHASE = 12;
#ifndef FLATBAR
#define FLATBAR 0
#endif
#ifndef XTRA_BAR
#define XTRA_BAR 0
#endif
#ifndef REP_ATT
#define REP_ATT 0
#endif
#ifndef PROBE_B
#define PROBE_B 0
#endif
#ifndef PROBE_10
#define PROBE_10 0
#endif
#ifndef FUSE_NORM
#define FUSE_NORM 1
#endif
#ifndef REP_C
#define REP_C 0
#define REP_A 0
#endif
#ifndef REPMASK
#define REPMASK 0
#endif
#ifndef TAILS
#define TAILS 1
#endif

__device__ __forceinline__ float bf2f(unsigned v) { return __uint_as_float(v << 16); }
typedef float f32x2_t __attribute__((ext_vector_type(2))); typedef __bf16 bf16x2_t __attribute__((ext_vector_type(2)));
__device__ __forceinline__ unsigned pkbf(float lo, float hi) { const f32x2_t v = {lo, hi}; const bf16x2_t b = __builtin_convertvector(v, bf16x2_t); return __builtin_bit_cast(unsigned, b); }
__device__ __forceinline__ float wave_sum(float v) {
#pragma unroll
    for (int o = 1; o < 64; o <<= 1) v += __shfl_xor(v, o);
    return v;
}
__device__ __forceinline__ float log_sigmoid(float x) { return fminf(x, 0.f) - log1pf(__expf(-fabsf(x))); }

template <bool UPPERM = false, bool NTST = false> __device__ __forceinline__ void p0_transpose_item(const float* W, int K, int N, bf16_t* WT, LAS float* scr, int item, int lane) {
    const int nblk = (N + 31) / 32, kb = item / nblk, nb = item % nblk, k0 = 64 * kb, n0 = 32 * nb;
    const int nd0 = UPPERM ? (n0 < 5632 ? (n0 >> 7) * 256 + (n0 & 127) : ((n0 - 5632) >> 7) * 256 + 128 + ((n0 - 5632) & 127)) : n0;
    const int c4 = (lane & 7) * 4, kr = lane >> 3; const bool okc = n0 + c4 < N;
    f32x4 v[8];
#pragma unroll
    for (int i = 0; i < 8; ++i) v[i] = okc ? __builtin_nontemporal_load((const f32x4*)(W + (size_t)(k0 + kr + 8 * i) * N + n0 + c4)) : (f32x4){0.f, 0.f, 0.f, 0.f};
#pragma unroll
    for (int i = 0; i < 8; ++i) { LAS float* d = scr + (kr + 8 * i) * 33 + c4; d[0] = v[i].x; d[1] = v[i].y; d[2] = v[i].z; d[3] = v[i].w; }
    asm volatile("s_waitcnt lgkmcnt(0)" ::: "memory");
    const int c = lane & 7;
#pragma unroll
    for (int j = 0; j < 4; ++j) { const int n = (lane >> 3) + 8 * j; const LAS float* s = scr + (8 * c) * 33 + n;
        u32x4 o; o.x = pkbf(s[0 * 33], s[1 * 33]); o.y = pkbf(s[2 * 33], s[3 * 33]); o.z = pkbf(s[4 * 33], s[5 * 33]); o.w = pkbf(s[6 * 33], s[7 * 33]);
        if (NTST) __builtin_nontemporal_store(o, (u32x4*)(WT + (size_t)(nd0 + n) * K + k0 + 8 * c)); else *(u32x4*)(WT + (size_t)(nd0 + n) * K + k0 + 8 * c) = o; }
    asm volatile("s_waitcnt lgkmcnt(0)" ::: "memory");
}
__device__ __forceinline__ void p0_gemv_item(const float* wmod, const float* bmod, float* modx, float* modc, char* lds, int item) {
    const int tid = ltid(); const float* sx = (const float*)lds; const float* sc = sx + 2048; float* red = (float*)(lds + 16384);
    const int n0 = item * 64, c4 = (tid & 15) * 4, kr = tid >> 4;
    f32x4 ax = {0.f, 0.f, 0.f, 0.f}, ac = {0.f, 0.f, 0.f, 0.f};
#pragma unroll 8
    for (int j = 0; j < 64; ++j) { const int k = kr + 32 * j; const f32x4 w = __builtin_nontemporal_load((const f32x4*)(wmod + (size_t)k * 12288 + n0 + c4)); ax += w * sx[k]; ac += w * sc[k]; }
    *(f32x4*)(red + (kr * 16 + (tid & 15)) * 8) = ax; *(f32x4*)(red + (kr * 16 + (tid & 15)) * 8 + 4) = ac;
    __syncthreads();
    if (tid < 128) { const int col = tid & 63, which = tid >> 6; float s = 0.f;
        for (int k2 = 0; k2 < 32; ++k2) s += red[(k2 * 16 + (col >> 2)) * 8 + which * 4 + (col & 3)];
        s += bmod[n0 + col]; (which ? modc : modx)[n0 + col] = s; }
    __syncthreads();
}
__device__ __forceinline__ void norm_mod_row(const float* xrow, const float* g, const float* sh, const float* sc, bf16_t* orow, int lane) {
    const f32x4* xr = (const f32x4*)xrow + lane; f32x4 v[8]; float s = 0.f;
#pragma unroll
    for (int j = 0; j < 8; ++j) { v[j] = __builtin_nontemporal_load(xr + 64 * j); s += (v[j].x * v[j].x + v[j].y * v[j].y) + (v[j].z * v[j].z + v[j].w * v[j].w); }
    const float rstd = rsqrtf(wave_sum(s) * (1.f / 2048.f) + EPS);
    u32x2* o8 = (u32x2*)orow + lane;
#pragma unroll
    for (int j = 0; j < 8; ++j) { const f32x4 gg = ((const f32x4*)g)[lane + 64 * j], s1 = ((const f32x4*)sc)[lane + 64 * j], s0 = ((const f32x4*)sh)[lane + 64 * j];
        const f32x4 y = (v[j] * rstd * gg) * (s1 + 1.0f) + s0; u32x2 w; w.x = pkbf(y.x, y.y); w.y = pkbf(y.z, y.w); o8[64 * j] = w; }
}
__device__ __forceinline__ void final_norm_row(float* xrow, const float* g, int lane) {
    f32x4* xr = (f32x4*)xrow + lane; f32x4 v[8]; float s = 0.f;
#pragma unroll
    for (int j = 0; j < 8; ++j) { v[j] = xr[64 * j]; s += (v[j].x * v[j].x + v[j].y * v[j].y) + (v[j].z * v[j].z + v[j].w * v[j].w); }
    const float rstd = rsqrtf(wave_sum(s) * (1.f / 2048.f) + EPS);
#pragma unroll
    for (int j = 0; j < 8; ++j) { const f32x4 gg = ((const f32x4*)g)[lane + 64 * j]; xr[64 * j] = v[j] * rstd * gg; }
}
constexpr int QK_TASKS = SEQ * 10 + CTXL * 2;
__device__ __forceinline__ void qk_prep_task(bf16_t* P, int t, const float* qn, const float* kn, int lane) {
    int row, hh; if (t < SEQ * 10) { row = t / 10; hh = t - row * 10; } else { const int t2 = t - SEQ * 10; row = SEQ + (t2 >> 1); hh = 8 + (t2 & 1); }
    const bool is_x = row < SEQ; const int sl = lane & 7, half = sl >> 2, i0 = (sl & 3) * 8, e1 = 64 * half + i0;
    bf16_t* hp = P + (size_t)row * NPROJ + (hh < 8 ? OFF_AQ + hh * 128 : OFF_AK + (hh - 8) * 128) + e1;
    const u32x4 ra = *(const u32x4*)hp, rb = *(const u32x4*)(hp + 32);
    const float* gn = (hh < 8 ? qn : kn) + e1;
    const f32x4 ga0 = *(const f32x4*)gn, ga1 = *(const f32x4*)(gn + 4), gb0 = *(const f32x4*)(gn + 32), gb1 = *(const f32x4*)(gn + 36);
    float x1[8], x2[8]; float ss = 0.f;
#pragma unroll
    for (int j = 0; j < 4; ++j) { x1[2 * j] = __uint_as_float(ra[j] << 16); x1[2 * j + 1] = __uint_as_float(ra[j] & 0xffff0000u); x2[2 * j] = __uint_as_float(rb[j] << 16); x2[2 * j + 1] = __uint_as_float(rb[j] & 0xffff0000u); }
#pragma unroll
    for (int j = 0; j < 8; ++j) ss += x1[j] * x1[j] + x2[j] * x2[j];
    ss += __shfl_xor(ss, 1); ss += __shfl_xor(ss, 2); ss += __shfl_xor(ss, 4);
    const float rstd = rsqrtf(ss * (1.f / 128.f) + EPS);
    const float pos = (float)(half == 0 ? (row >> 6) : (row & 63));
    float o1[8], o2[8];
#pragma unroll
    for (int j = 0; j < 8; ++j) {
        float cs = 1.f, sn = 0.f;
        if (is_x) { const float invf = exp2f(-(float)(i0 + j) * (13.287712379549449f / 32.0f));
            const float rev = pos * invf * 0.15915494309189535f; cs = __builtin_amdgcn_cosf(rev); sn = __builtin_amdgcn_sinf(rev); }
        const float y1 = x1[j] * rstd * (j < 4 ? ga0[j & 3] : ga1[j & 3]), y2 = x2[j] * rstd * (j < 4 ? gb0[j & 3] : gb1[j & 3]);
        o1[j] = y1 * cs - y2 * sn; o2[j] = y2 * cs + y1 * sn; }
    u32x4 wa, wb;
#pragma unroll
    for (int j = 0; j < 4; ++j) { wa[j] = pkbf(o1[2 * j], o1[2 * j + 1]); wb[j] = pkbf(o2[2 * j], o2[2 * j + 1]); }
    *(u32x4*)hp = wa; *(u32x4*)(hp + 32) = wb;
}
__device__ __forceinline__ void gate_scan(const float* G, const float* b_i, const float* b_f, int row0, int h, int dir, int lane, float& b, float& ip, float& bL) {
    const float* g = G + (size_t)(row0 + lane) * 16 + dir * 8;
    ip = g[h] + b_i[dir * 4 + h];
    b = log_sigmoid(g[4 + h] + b_f[dir * 4 + h]);
    if (dir == 0) {
#pragma unroll
        for (int o = 1; o < 64; o <<= 1) { const float v = __shfl_up(b, o); if (lane >= o) b += v; }
        bL = __shfl(b, 63);
    } else {
#pragma unroll
        for (int o = 1; o < 64; o <<= 1) { const float v = __shfl_down(b, o); if (lane + o < 64) b += v; }
        bL = __shfl(b, 0);
    }
}
__device__ __forceinline__ s16x4 vtr(const LAS char* p) { typedef short v4i16_t __attribute__((ext_vector_type(4)));
    return __builtin_bit_cast(s16x4, __builtin_amdgcn_ds_read_tr16_b64_v4i16((LAS v4i16_t*)p)); }
__device__ __forceinline__ bf16x8 trfrag(const LAS char* base, int off) { const s16x4 l = vtr(base + off), h = vtr(base + off + 2048);
    return (bf16x8){l[0], l[1], l[2], l[3], h[0], h[1], h[2], h[3]}; }
__device__ __forceinline__ bf16x8 scale8(bf16x8 k, float w) { const u32x4 u = __builtin_bit_cast(u32x4, k); u32x4 o;
#pragma unroll
    for (int j = 0; j < 4; ++j) o[j] = pkbf(__uint_as_float(u[j] << 16) * w, __uint_as_float(u[j] & 0xffff0000u) * w);
    return __builtin_bit_cast(bf16x8, o); }
__device__ __forceinline__ bf16x8 pack8(f32x4 a, f32x4 b) { u32x4 o; o.x = pkbf(a.x, a.y); o.y = pkbf(a.z, a.w); o.z = pkbf(b.x, b.y); o.w = pkbf(b.z, b.w); return __builtin_bit_cast(bf16x8, o); }
__device__ __forceinline__ int step_of(int dir, int c) { return dir == 0 ? (c < 128 ? c + 4 : c - 128) : 131 - c; }

__device__ __forceinline__ void mlstm_passA(char* lds, const bf16_t* P, const float* G, const float* b_i, const float* b_f, bf16_t* ST, float* BL, int item) {
    const int tid = ltid(), wid = tid >> 6, lane = tid & 63, r32 = lane & 31, hi = lane >> 5;
    const int c = item >> 2, h = item & 3, row0 = c * 64;
    float* wts = (float*)(lds + 65536);
    if (wid < 2) { float b, ip, bL; gate_scan(G, b_i, b_f, row0, h, wid, lane, b, ip, bL); wts[wid * 64 + lane] = __expf(bL - b + ip);
        if (lane == 0) BL[(wid * 4 + h) * NSTEP + step_of(wid, c)] = bL; }
    __syncthreads();
#pragma unroll
    for (int i = 0; i < 4; ++i) { const int p = tid + 512 * i, r = p >> 5, cc = (p & 31) * 8;
        const bf16x8 v = *(const bf16x8*)(P + (size_t)(row0 + r) * NPROJ + OFF_MV + h * 256 + cc);
        *(bf16x8*)(lds + (cc >> 7) * 16384 + att::v_st(r, cc & 127)) = v; }
#pragma unroll
    for (int i = 0; i < 2; ++i) { const int p = tid + 512 * i, r = p >> 4, cc = (p & 15) * 8;
        const bf16x8 k = *(const bf16x8*)(P + (size_t)(row0 + r) * NPROJ + OFF_MK + h * 128 + cc);
        *(bf16x8*)(lds + 32768 + att::v_st(r, cc)) = scale8(k, wts[r]); *(bf16x8*)(lds + 49152 + att::v_st(r, cc)) = scale8(k, wts[64 + r]); }
    __syncthreads();
    const int dir = wid >> 2, cb = wid & 3;
    const LAS char* L = (const LAS char*)lds + att::v_rd_base(lane);
    const LAS char* La = L + (cb >> 1) * 16384 + ((2 * cb) & 3) * 512;
    const LAS char* Lb = L + 32768 + dir * 16384;
    bf16_t* base = ST + ((size_t)(dir * 4 + h) * NSTEP + step_of(dir, c)) * ST_BLK;
#pragma nounroll
    for (int a = 0; a < 2; ++a) {
        f32x16 acc[4];
#pragma unroll
        for (int b = 0; b < 4; ++b) acc[b] = f32x16{};
        const LAS char* Laa = La + a * 512;
#pragma unroll
        for (int ks = 0; ks < 4; ++ks) {
            const bf16x8 A = trfrag(Laa, ks * 4096);
#pragma unroll
            for (int b = 0; b < 4; ++b) acc[b] = __builtin_amdgcn_mfma_f32_32x32x16_bf16(A, trfrag(Lb, b * 512 + ks * 4096), acc[b], 0, 0, 0);
        }
#pragma unroll
        for (int b = 0; b < 4; ++b)
#pragma unroll
            for (int r = 0; r < 16; ++r) base[(size_t)(64 * cb + 32 * a + crow(r, hi)) * 128 + 32 * b + r32] = (bf16_t)(pkbf(acc[b][r], acc[b][r]) & 0xffffu);
    }
    if (cb == 0) {
        f32x16 an[4];
#pragma unroll
        for (int b = 0; b < 4; ++b) an[b] = f32x16{};
        const short one = (r32 == 0) ? (short)0x3F80 : (short)0; const bf16x8 A1 = {one, one, one, one, one, one, one, one};
#pragma unroll
        for (int ks = 0; ks < 4; ++ks)
#pragma unroll
            for (int b = 0; b < 4; ++b) an[b] = __builtin_amdgcn_mfma_f32_32x32x16_bf16(A1, trfrag(Lb, b * 512 + ks * 4096), an[b], 0, 0, 0);
        if (hi == 0) {
#pragma unroll
            for (int b = 0; b < 4; ++b) base[(size_t)256 * 128 + 32 * b + r32] = (bf16_t)(pkbf(an[b][0], an[b][0]) & 0xffffu);
        }
    }
    __syncthreads();
}
__device__ __forceinline__ void mlstm_passB(bf16_t* ST, const float* BL, bf16_t* DST = nullptr, int ndh = 8) {
    constexpr int PER = (int)(ST_BLK / 2); constexpr size_t SB = ST_BLK / 2;
    const int nthr = gridDim.x * 512;
    for (int e = blockIdx.x * 512 + ltid(); e < ndh * PER; e += nthr) {
        const int dh = e / PER, idx = e - dh * PER;
        unsigned* p = (unsigned*)(ST + (size_t)dh * NSTEP * ST_BLK) + idx; const float* bl = BL + dh * NSTEP;
        unsigned* q = DST ? (unsigned*)(DST + (size_t)dh * NSTEP * ST_BLK) + idx : p;
        float c0 = 0.f, c1 = 0.f;
        unsigned cur[12], nxt[12];
#pragma unroll
        for (int j = 0; j < 12; ++j) cur[j] = p[(size_t)j * SB];
        for (int s = 0; s < NSTEP; s += 12) {
#pragma unroll
            for (int j = 0; j < 12; ++j) nxt[j] = (s + 12 + j < NSTEP) ? p[(size_t)(s + 12 + j) * SB] : 0u;
#pragma unroll
            for (int j = 0; j < 12; ++j) { const float d = __expf(bl[s + j]);
                q[(size_t)(s + j) * SB] = pkbf(c0, c1);
                c0 = c0 * d + __uint_as_float(cur[j] << 16); c1 = c1 * d + __uint_as_float(cur[j] & 0xffff0000u); }
#pragma unroll
            for (int j = 0; j < 12; ++j) cur[j] = nxt[j];
        }
    }
}
__device__ __forceinline__ void mlstm_passC(char* lds, const bf16_t* P, const float* G, const float* b_i, const float* b_f, const bf16_t* ST, const float* mnorm, bf16_t* MIX, int item) {
    const int tid = ltid(), wid = tid >> 6, lane = tid & 63, r32 = lane & 31, hi = lane >> 5;
    const int c = item >> 2, h = item & 3, row0 = c * 64;
    float* bq = (float*)(lds + 49152); float* ak = bq + 128; float* eq = ak + 128; float* ssq = eq + 128;
    if (wid < 2) { float b, ip, bL; gate_scan(G, b_i, b_f, row0, h, wid, lane, b, ip, bL); bq[wid * 64 + lane] = b; ak[wid * 64 + lane] = b - ip; eq[wid * 64 + lane] = __expf(b); }
    { const int sr = tid >> 4, sc = (tid & 15) * 8;
#pragma unroll
      for (int i = 0; i < 2; ++i) { const int r = sr + 32 * i; const bf16x8 k = *(const bf16x8*)(P + (size_t)(row0 + r) * NPROJ + OFF_MK + h * 128 + sc);
          *(bf16x8*)(lds + KSWZ(r, sc * 2)) = k; } }
#pragma unroll
    for (int i = 0; i < 4; ++i) { const int p = tid + 512 * i, r = p >> 5, cc = (p & 31) * 8;
        const bf16x8 v = *(const bf16x8*)(P + (size_t)(row0 + r) * NPROJ + OFF_MV + h * 256 + cc);
        *(bf16x8*)(lds + 16384 + (cc >> 7) * 16384 + att::v_st(r, cc & 127)) = v; }
    const int rb = wid >> 2, cb = wid & 3, q = 32 * rb + r32;
    bf16x8 qr[8];
    { const bf16_t* Qw = P + (size_t)(row0 + q) * NPROJ + OFF_MQ + h * 128 + hi * 8;
#pragma unroll
      for (int d0 = 0; d0 < 8; ++d0) qr[d0] = *(const bf16x8*)(Qw + d0 * 16); }
    bf16x8 fr[3][8];
#define LOAD_FR(d) do { const bf16_t* base_ = ST + ((size_t)((d) * 4 + h) * NSTEP + step_of((d), c)) * ST_BLK; \
        _Pragma("unroll") for (int t = 0; t < 3; ++t) { const bf16_t* src = base_ + (size_t)(t < 2 ? 64 * cb + 32 * t + r32 : 256) * 128 + 8 * hi; \
            _Pragma("unroll") for (int ks = 0; ks < 8; ++ks) { fr[t][ks] = (bf16x8){0, 0, 0, 0, 0, 0, 0, 0}; if (t < 2 || r32 == 0) fr[t][ks] = *(const bf16x8*)(src + 16 * ks); } } } while (0)
    LOAD_FR(0);
    __syncthreads();
    f32x16 acc[2][3];
#pragma unroll
    for (int d = 0; d < 2; ++d)
#pragma unroll
        for (int t = 0; t < 3; ++t) acc[d][t] = f32x16{};
#pragma unroll
    for (int d = 0; d < 2; ++d) {
        if (d == 1) LOAD_FR(1);
#pragma unroll
        for (int t = 0; t < 3; ++t)
#pragma unroll
            for (int ks = 0; ks < 8; ++ks) acc[d][t] = __builtin_amdgcn_mfma_f32_32x32x16_bf16(qr[ks], fr[t][ks], acc[d][t], 0, 0, 0);
#pragma unroll
        for (int r = 0; r < 16; ++r) { const float e = eq[d * 64 + 32 * rb + crow(r, hi)];
#pragma unroll
            for (int t = 0; t < 3; ++t) acc[d][t][r] *= e; }
    }
#undef LOAD_FR
    float ogv[2][16], mnv[2];
#pragma unroll
    for (int t = 0; t < 2; ++t) { const int col = 64 * cb + 32 * t + r32; mnv[t] = mnorm[h * 256 + col];
#pragma unroll
        for (int r = 0; r < 16; ++r) ogv[t][r] = bf2f(P[(size_t)(row0 + 32 * rb + crow(r, hi)) * NPROJ + OFF_MO + h * 256 + col]); }
    f32x16 p0, p1; att::qkt(p0, p1, (const bf16_t*)lds, qr, r32, hi);
    const LAS char* Lv = (const LAS char*)lds + 16384 + att::v_rd_base(lane) + (cb >> 1) * 16384 + ((2 * cb) & 3) * 512;
    const short one = (r32 == 0) ? (short)0x3F80 : (short)0; const bf16x8 B1 = {one, one, one, one, one, one, one, one};
#pragma unroll
    for (int d = 0; d < 2; ++d) {
        const float bqv = bq[d * 64 + q]; f32x16 e0, e1;
#pragma unroll
        for (int r = 0; r < 16; ++r) { const int k0 = crow(r, hi), k1 = 32 + k0;
            const bool v0 = d == 0 ? (k0 <= q) : (k0 >= q), v1 = d == 0 ? (k1 <= q) : (k1 >= q);
            const float x0 = __expf(bqv - ak[d * 64 + k0]), x1 = __expf(bqv - ak[d * 64 + k1]);
            e0[r] = v0 ? p0[r] * x0 : 0.f; e1[r] = v1 ? p1[r] * x1 : 0.f; }
        bf16x8 pa0, pa1, pa2, pa3; PK4(e0, 0, pa0); PK4(e0, 8, pa1); PK4(e1, 0, pa2); PK4(e1, 8, pa3);
#pragma unroll
        for (int t = 0; t < 2; ++t) {
            acc[d][t] = __builtin_amdgcn_mfma_f32_32x32x16_bf16(pa0, trfrag(Lv, t * 512 + 0 * 4096), acc[d][t], 0, 0, 0);
            acc[d][t] = __builtin_amdgcn_mfma_f32_32x32x16_bf16(pa1, trfrag(Lv, t * 512 + 1 * 4096), acc[d][t], 0, 0, 0);
            acc[d][t] = __builtin_amdgcn_mfma_f32_32x32x16_bf16(pa2, trfrag(Lv, t * 512 + 2 * 4096), acc[d][t], 0, 0, 0);
            acc[d][t] = __builtin_amdgcn_mfma_f32_32x32x16_bf16(pa3, trfrag(Lv, t * 512 + 3 * 4096), acc[d][t], 0, 0, 0);
        }
        acc[d][2] = __builtin_amdgcn_mfma_f32_32x32x16_bf16(pa0, B1, acc[d][2], 0, 0, 0);
        acc[d][2] = __builtin_amdgcn_mfma_f32_32x32x16_bf16(pa1, B1, acc[d][2], 0, 0, 0);
        acc[d][2] = __builtin_amdgcn_mfma_f32_32x32x16_bf16(pa2, B1, acc[d][2], 0, 0, 0);
        acc[d][2] = __builtin_amdgcn_mfma_f32_32x32x16_bf16(pa3, B1, acc[d][2], 0, 0, 0);
    }
    f32x16 hv[2];
#pragma unroll
    for (int r = 0; r < 16; ++r) {
        const int f0 = __builtin_amdgcn_readlane(__float_as_int(acc[0][2][r]), 0), f1 = __builtin_amdgcn_readlane(__float_as_int(acc[0][2][r]), 32);
        const int g0 = __builtin_amdgcn_readlane(__float_as_int(acc[1][2][r]), 0), g1 = __builtin_amdgcn_readlane(__float_as_int(acc[1][2][r]), 32);
        const float df = __int_as_float(hi ? f1 : f0), db = __int_as_float(hi ? g1 : g0);
        const float invf = __builtin_amdgcn_rcpf(fmaxf(fabsf(df), 1.0f)), invb = __builtin_amdgcn_rcpf(fmaxf(fabsf(db), 1.0f));
        hv[0][r] = acc[0][0][r] * invf + acc[1][0][r] * invb; hv[1][r] = acc[0][1][r] * invf + acc[1][1][r] * invb;
    }
    { float s16[16];
#pragma unroll
      for (int r = 0; r < 16; ++r) s16[r] = hv[0][r] * hv[0][r] + hv[1][r] * hv[1][r];
      float s8[8], s4[4], s2[2], s1;
#pragma unroll
      for (int r = 0; r < 8; ++r) { const float keep = (lane & 16) ? s16[8 + r] : s16[r], give = (lane & 16) ? s16[r] : s16[8 + r]; s8[r] = keep + __shfl_xor(give, 16); }
#pragma unroll
      for (int r = 0; r < 4; ++r) { const float keep = (lane & 8) ? s8[4 + r] : s8[r], give = (lane & 8) ? s8[r] : s8[4 + r]; s4[r] = keep + __shfl_xor(give, 8); }
#pragma unroll
      for (int r = 0; r < 2; ++r) { const float keep = (lane & 4) ? s4[2 + r] : s4[r], give = (lane & 4) ? s4[r] : s4[2 + r]; s2[r] = keep + __shfl_xor(give, 4); }
      { const float keep = (lane & 2) ? s2[1] : s2[0], give = (lane & 2) ? s2[0] : s2[1]; s1 = keep + __shfl_xor(give, 2); }
      s1 += __shfl_xor(s1, 1);
      const int rr = ((lane >> 4) & 1) * 8 + ((lane >> 3) & 1) * 4 + ((lane >> 2) & 1) * 2 + ((lane >> 1) & 1);
      if ((lane & 1) == 0) ssq[cb * 64 + 32 * rb + crow(rr, hi)] = s1; }
    __syncthreads();
#pragma unroll
    for (int r = 0; r < 16; ++r) { const int row = 32 * rb + crow(r, hi); const float rstd = rsqrtf(((ssq[row] + ssq[64 + row]) + (ssq[128 + row] + ssq[192 + row])) * (1.f / 256.f) + EPS);
#pragma unroll
        for (int t = 0; t < 2; ++t) { const int col = 64 * cb + 32 * t + r32;
            const float val = hv[t][r] * rstd * mnv[t] * ogv[t][r];
            MIX[(size_t)(row0 + row) * DM + 1024 + h * 256 + col] = (bf16_t)(pkbf(val, val) & 0xffffu); } }
    __syncthreads();
}
template <int ROWS> __device__ __forceinline__ void conv_gate_item(const bf16_t* U, const float* cw, const float* cbias, bf16_t* ACT, int item) {
    const int cgp = item % 704, rr = item / 704, j0 = cgp * 8, t0 = rr * ROWS;
    float w0g[8], w1g[8], w2g[8], bg[8], w0v[8], w1v[8], w2v[8], bv[8];
#pragma unroll
    for (int j = 0; j < 8; ++j) { w0g[j] = cw[j0 + j]; w1g[j] = cw[NUP + j0 + j]; w2g[j] = cw[2 * NUP + j0 + j]; bg[j] = cbias[j0 + j];
        w0v[j] = cw[DFF + j0 + j]; w1v[j] = cw[NUP + DFF + j0 + j]; w2v[j] = cw[2 * NUP + DFF + j0 + j]; bv[j] = cbias[DFF + j0 + j]; }
    const u32x4 z = {0u, 0u, 0u, 0u};
    u32x4 Gr[ROWS + 2], Vr[ROWS + 2];
#pragma unroll
    for (int i = 0; i < ROWS + 2; ++i) { const int t = t0 - 1 + i; Gr[i] = z; Vr[i] = z;
        if (t >= 0 && t < SEQ) { Gr[i] = __builtin_nontemporal_load((const u32x4*)(U + (size_t)t * NUP + j0)); Vr[i] = __builtin_nontemporal_load((const u32x4*)(U + (size_t)t * NUP + DFF + j0)); } }
#pragma unroll
    for (int i = 0; i < ROWS; ++i) {
        u32x4 o;
#pragma unroll
        for (int jj = 0; jj < 4; ++jj) { float r2[2];
#pragma unroll
            for (int e = 0; e < 2; ++e) { const int j = 2 * jj + e;
                const float a = e ? __uint_as_float(Gr[i][jj] & 0xffff0000u) : __uint_as_float(Gr[i][jj] << 16);
                const float b = e ? __uint_as_float(Gr[i + 1][jj] & 0xffff0000u) : __uint_as_float(Gr[i + 1][jj] << 16);
                const float d = e ? __uint_as_float(Gr[i + 2][jj] & 0xffff0000u) : __uint_as_float(Gr[i + 2][jj] << 16);
                const float av = e ? __uint_as_float(Vr[i][jj] & 0xffff0000u) : __uint_as_float(Vr[i][jj] << 16);
                const float bvv = e ? __uint_as_float(Vr[i + 1][jj] & 0xffff0000u) : __uint_as_float(Vr[i + 1][jj] << 16);
                const float dv = e ? __uint_as_float(Vr[i + 2][jj] & 0xffff0000u) : __uint_as_float(Vr[i + 2][jj] << 16);
                const float gc = w0g[j] * a + w1g[j] * b + w2g[j] * d + bg[j];
                const float vc = w0v[j] * av + w1v[j] * bvv + w2v[j] * dv + bv[j];
                r2[e] = gc * __builtin_amdgcn_rcpf(1.0f + __builtin_amdgcn_exp2f(-1.4426950408889634f * gc)) * vc; }
            o[jj] = pkbf(r2[0], r2[1]); }
        *(u32x4*)(ACT + (size_t)(t0 + i) * DFF + j0) = o;
    }
}
__device__ __forceinline__ void flat_barrier(unsigned* cnt, unsigned target) {
    asm volatile("s_waitcnt vmcnt(0)" ::: "memory");
    __syncthreads();
    if (threadIdx.x == 0) {
        __builtin_amdgcn_fence(__ATOMIC_RELEASE, "agent");
        asm volatile("s_waitcnt vmcnt(0)" ::: "memory");
        __hip_atomic_fetch_add(cnt, 1u, __ATOMIC_RELAXED, __HIP_MEMORY_SCOPE_AGENT);
        unsigned sp = 0;
        while (__hip_atomic_load(cnt, __ATOMIC_RELAXED, __HIP_MEMORY_SCOPE_AGENT) < target) { __builtin_amdgcn_s_sleep(1); if (++sp > (1u << 22)) break; }
        __builtin_amdgcn_fence(__ATOMIC_ACQUIRE, "agent");
        asm volatile("s_waitcnt vmcnt(0)" ::: "memory");
    }
    __syncthreads();
}
struct Args { const float* in[20]; float* out; unsigned char* ws; int ph_lo, ph_hi, coop, pad; };

__global__ void __launch_bounds__(512) fwd_kernel(Args a) {
    extern __shared__ __attribute__((aligned(16))) unsigned char lds[];
    const int G_ = gridDim.x, bid = blockIdx.x; const int NGW = G_ * 8;
#define TIDS const int tid = ltid(), lane = tid & 63, wave = __builtin_amdgcn_readfirstlane(tid >> 6), gw = bid * 8 + wave; (void)tid; (void)lane; (void)gw
#define x_in (a.in[0])
#define cvec (a.in[1])
#define ctx (a.in[2])
#define cctx (a.in[3])
#define wmod (a.in[4])
#define bmod (a.in[5])
#define norm1 (a.in[6])
#define w_in (a.in[7])
#define qn (a.in[8])
#define kn (a.in[9])
#define b_ig (a.in[10])
#define b_fg (a.in[11])
#define mnorm (a.in[12])
#define w_out (a.in[13])
#define norm2 (a.in[14])
#define w_up (a.in[15])
#define convw (a.in[16])
#define convb (a.in[17])
#define w_down (a.in[18])
#define normf (a.in[19])
#define outp (a.out)
#define modx ((float*)(a.ws + WS_MODX))
#define modc ((float*)(a.ws + WS_MODC))
#define BL ((float*)(a.ws + WS_BL))
#define Gt ((float*)(a.ws + WS_G))
#define Wdown_t ((bf16_t*)(a.ws + WS_WDOWN))
#define Win_t ((bf16_t*)(a.ws + WS_WIN))
#define Wout_t ((bf16_t*)(a.ws + WS_WOUT))
#define Wup_t ((bf16_t*)(a.ws + WS_WUP))
#define H ((bf16_t*)(a.ws + WS_H))
#define MIX ((bf16_t*)(a.ws + WS_MIX))
#define ACT ((bf16_t*)(a.ws + WS_ACT))
#define P ((bf16_t*)(a.ws + WS_P))
#define ST ((bf16_t*)(a.ws + WS_ST))
#define U ((bf16_t*)(a.ws + WS_U))
    const int lo = a.ph_lo, hi_ = a.ph_hi;
#ifndef PH_MASK
#define PH_MASK 0xfff
#endif
#define IN(k) (((PH_MASK >> (k)) & 1) && lo <= (k) && (k) < hi_)
#if FLATBAR
    unsigned bar_epoch = 0;
#define SEAM(k) do { if (IN(k) && IN((k) + 1)) { bar_epoch += gridDim.x; flat_barrier((unsigned*)(a.ws + WS_BAR) + 64, bar_epoch); } } while (0)
#else
#define SEAM(k) do { if (IN(k) && IN((k) + 1)) xcd_barrier(bar); } while (0)
#endif
    if (threadIdx.x < 32) ((volatile LAS unsigned*)((LAS unsigned char*)lds + 131072))[threadIdx.x] = 0u;
    __syncthreads();
    XcdBarrier bar; bar.bar = (unsigned*)(a.ws + WS_BAR); bar.x = 0; bar.st = nullptr;
    if (a.coop) { bar = xcd_barrier_post((unsigned*)(a.ws + WS_BAR), (volatile LAS unsigned*)((LAS unsigned char*)lds + 131072)); cg::this_grid().sync(); }

    for (int rep_ = 0; rep_ < (IN(0) ? 1 + ((REPMASK >> 0) & 1) : 0); ++rep_) { TIDS;
        float* sx = (float*)lds;
        for (int i = tid; i < 2048; i += 512) { const float v = cvec[i]; sx[i] = v / (1.0f + __expf(-v)); const float w = cctx[i]; sx[2048 + i] = w / (1.0f + __expf(-w)); }
        __syncthreads();
        for (int it = bid; it < 192; it += G_) p0_gemv_item(wmod, bmod, modx, modc, (char*)lds, it);
        LAS float* scr = (LAS float*)((LAS unsigned char*)lds + 32768 + wave * 8448);
        constexpr int I_IN = 32 * 145;
        for (int it = gw; it < I_IN; it += NGW) p0_transpose_item(w_in, DM, INPROJ, Win_t, scr, it, lane);
#if !TAILS
        { constexpr int I_OUT = 32 * 64, I_UP = 32 * 352, I_DOWN = 88 * 64;
          for (int it = gw; it < I_OUT + I_UP + I_DOWN; it += NGW) { if (it < I_OUT) p0_transpose_item(w_out, DM, DM, Wout_t, scr, it, lane); else if (it < I_OUT + I_UP) p0_transpose_item(w_up, DM, NUP, Wup_t, scr, it - I_OUT, lane);
              else p0_transpose_item(w_down, DFF, DM, Wdown_t, scr, it - I_OUT - I_UP, lane); } }
#endif
    }
    SEAM(0);
#if XTRA_BAR
    for (int xb_ = 0; xb_ < XTRA_BAR; ++xb_) SEAM(0);
#endif
    for (int rep_ = 0; rep_ < (IN(1) ? 1 + ((REPMASK >> 1) & 1) : 0); ++rep_) { TIDS;
        for (int m = gw; m < MROWS; m += NGW) { const bool isx = m < SEQ; const float* md = isx ? modx : modc;
            norm_mod_row(isx ? x_in + (size_t)m * DM : ctx + (size_t)(m - SEQ) * DM, norm1, md, md + 2048, H + (size_t)m * DM, lane); }
    }
    SEAM(1);
    for (int rep_ = 0; rep_ < (IN(2) ? 1 + ((REPMASK >> 2) & 1) : 0); ++rep_) {
        pg8::Gemm g{H, Win_t, MROWS, NPROJ_PAD, DM}; pg8::StaticOrder S; S.init(MROWS, NPROJ_PAD, G_, bid);
        pg8::EpiInProj E{P, Gt};
        pg8::gemm_phase<pg8::EpiInProj, pg8::StaticOrder, true, true>((LAS unsigned char*)lds, g, S, E);
#if TAILS
        { TIDS; constexpr int NWG = (MROWS / 256) * (NPROJ_PAD / 256); const int R = (NWG + G_ - 1) / G_, thr = NWG - (R - 1) * G_, NL = R * G_ - NWG;
          LAS float* scr = (LAS float*)((LAS unsigned char*)lds + 32768 + wave * 8448);
          constexpr int I_OUT = 32 * 64, I_UP = 32 * 352;
          const int lw = NL > 0 ? (bid - thr) * 8 + wave : gw, nlw = NL > 0 ? NL * 8 : NGW;
          if (NL == 0 || bid >= thr)
              for (int it = lw; it < I_OUT + I_UP; it += nlw) { if (it < I_OUT) p0_transpose_item<false, true>(w_out, DM, DM, Wout_t, scr, it, lane); else p0_transpose_item<false, true>(w_up, DM, NUP, Wup_t, scr, it - I_OUT, lane); } }
#endif
        __syncthreads();
    }
    SEAM(2);
    for (int rep_ = 0; rep_ < (IN(3) ? 1 + ((REPMASK >> 3) & 1) : 0); ++rep_) { TIDS;
        for (int ra_ = 0; ra_ < 1 + REP_A; ++ra_)
        for (int it = bid; it < NSTEP * 4; it += G_) mlstm_passA((char*)lds, P, Gt, b_ig, b_fg, ST, BL, it);
        for (int wi = gw; wi < QK_TASKS / 8; wi += NGW) qk_prep_task(P, wi * 8 + (lane >> 3), qn, kn, lane);
    }
    SEAM(3);
#if PROBE_B
    if (IN(4)) mlstm_passB(ST, BL, (bf16_t*)outp, 7);
#endif
    if (IN(4)) mlstm_passB(ST, BL);
    SEAM(4);
    for (int rep_ = 0; rep_ < (IN(5) ? 1 + ((REPMASK >> 5) & 1) : 0); ++rep_) {
#ifndef P5_SKIP_ATT
        for (int rt_ = 0; rt_ < 1 + REP_ATT; ++rt_)
        for (int u = bid; u < 256; u += G_) { const int hq = u & 7, qb = u >> 3, kvh = hq >> 2;
            att::attn_dense_body(P + (size_t)(qb * 256) * NPROJ + OFF_AQ + hq * 128, P + OFF_AK + kvh * 128, P + OFF_AV + kvh * 128,
                                 MIX + (size_t)(qb * 256) * DM + hq * 128, MROWS, (char*)lds);
            __syncthreads(); }
#endif
#ifndef P5_SKIP_C
        for (int rc_ = 0; rc_ < 1 + REP_C; ++rc_)
        for (int it = bid; it < 128 * 4; it += G_) mlstm_passC((char*)lds, P, Gt, b_ig, b_fg, ST, mnorm, MIX, it);
#endif
    }
    SEAM(5);
    for (int rep_ = 0; rep_ < (IN(6) ? 1 : 0); ++rep_) {
        pg8::Gemm g{MIX, Wout_t, SEQ, DM, DM}; pg8::StaticOrder S; S.init(SEQ, DM, G_, bid);
        if (G_ == 256 && FUSE_NORM) {
            pg8::EpiResidNormMod E{x_in, outp, modx + 4096, norm2, modx + 6144, modx + 8192, H, pg8::RowStats{(float*)(a.ws + WS_SLOT1), (unsigned*)(a.ws + WS_CNT1)}};
            pg8::gemm_phase<pg8::EpiResidNormMod, pg8::StaticOrder, false, true>((LAS unsigned char*)lds, g, S, E);
        } else {
            pg8::EpiResid E{x_in, outp, modx + 4096};
            pg8::gemm_phase<pg8::EpiResid, pg8::StaticOrder, true, true>((LAS unsigned char*)lds, g, S, E);
        }
    }
    if (!(G_ == 256 && FUSE_NORM)) {
    SEAM(6);
    for (int rep_ = 0; rep_ < (IN(7) ? 1 : 0); ++rep_) { TIDS;
        for (int m = gw; m < SEQ; m += NGW) norm_mod_row(outp + (size_t)m * DM, norm2, modx + 6144, modx + 8192, H + (size_t)m * DM, lane);
    }
    }
    SEAM(7);
    for (int rep_ = 0; rep_ < (IN(8) ? 1 + ((REPMASK >> 8) & 1) : 0); ++rep_) {
        pg8::Gemm g{H, Wup_t, SEQ, NUP, DM}; pg8::StaticOrder S; S.init(SEQ, NUP, G_, bid);
        pg8::EpiBf16<0> E{U, NUP};
        pg8::gemm_phase<pg8::EpiBf16<0>, pg8::StaticOrder, true, true>((LAS unsigned char*)lds, g, S, E);
#if TAILS
        { TIDS; constexpr int NWG = (SEQ / 256) * (NUP / 256); const int R = (NWG + G_ - 1) / G_, thr = NWG - (R - 1) * G_, NL = R * G_ - NWG;
          LAS float* scr = (LAS float*)((LAS unsigned char*)lds + 32768 + wave * 8448);
          constexpr int I_DOWN = 88 * 64;
          const int lw = NL > 0 ? (bid - thr) * 8 + wave : gw, nlw = NL > 0 ? NL * 8 : NGW;
          if (NL == 0 || bid >= thr)
              for (int it = lw; it < I_DOWN; it += nlw) p0_transpose_item(w_down, DFF, DM, Wdown_t, scr, it, lane); }
#endif
        __syncthreads();
    }
    SEAM(8);
    for (int rep_ = 0; rep_ < (IN(9) ? 1 + ((REPMASK >> 9) & 1) : 0); ++rep_) { TIDS;
        for (int it = bid * 512 + tid; it < 704 * (SEQ / 16); it += G_ * 512) conv_gate_item<16>(U, convw, convb, ACT, it);
    }
    SEAM(9);
    for (int rep_ = 0; rep_ < (IN(10) ? 1 : 0); ++rep_) {
        pg8::Gemm g{ACT, Wdown_t, SEQ, DM, DFF}; pg8::StaticOrder S; S.init(SEQ, DM, G_, bid);
        if (G_ == 256 && FUSE_NORM) {
            pg8::EpiResidNorm E{outp, outp, modx + 10240, normf, pg8::RowStats{(float*)(a.ws + WS_SLOT2), (unsigned*)(a.ws + WS_CNT2)}};
            pg8::gemm_phase<pg8::EpiResidNorm, pg8::StaticOrder, false, true>((LAS unsigned char*)lds, g, S, E);
        } else {
            pg8::EpiResid E{outp, outp, modx + 10240};
            pg8::gemm_phase<pg8::EpiResid, pg8::StaticOrder, true, true>((LAS unsigned char*)lds, g, S, E);
        }
    }
    if (!(G_ == 256 && FUSE_NORM)) {
    SEAM(10);
    for (int rep_ = 0; rep_ < (IN(11) ? 1 : 0); ++rep_) { TIDS;
        for (int m = gw; m < SEQ; m += NGW) final_norm_row(outp + (size_t)m * DM, normf, lane);
    }
    }
#undef IN
#undef SEAM
#undef x_in
#undef cvec
#undef ctx
#undef cctx
#undef wmod
#undef bmod
#undef norm1
#undef w_in
#undef qn
#undef kn
#undef b_ig
#undef b_fg
#undef mnorm
#undef w_out
#undef norm2
#undef w_up
#undef convw
#undef convb
#undef w_down
#undef normf
#undef outp
#undef modx
#undef modc
#undef BL
#undef Gt
#undef Wdown_t
#undef Win_t
#undef Wout_t
#undef Wup_t
#undef H
#undef MIX
#undef ACT
#undef P
#undef ST
#undef U
}

#ifndef N_LAUNCH_MODE
#define N_LAUNCH_MODE 1
#endif
extern "C" void kernel_launch(void* const* d_in, const int* in_sizes, int n_in, void* d_out, int out_size, void* d_ws, size_t ws_size, hipStream_t stream) {
    static int grid = 0;
    if (grid == 0) {
        if (n_in != 20 || ws_size < WS_END) { fprintf(stderr, "kernel_launch: unexpected n_in %d / ws %zu\n", n_in, ws_size); grid = -1; return; }
        int dev = 0, cus = 0, per_cu = 0;
        hipGetDevice(&dev); hipDeviceGetAttribute(&cus, hipDeviceAttributeMultiprocessorCount, dev);
        hipFuncSetAttribute((const void*)fwd_kernel, hipFuncAttributeMaxDynamicSharedMemorySize, LDS_BYTES);
        hipOccupancyMaxActiveBlocksPerMultiprocessor(&per_cu, (const void*)fwd_kernel, 512, LDS_BYTES);
        if (per_cu < 1) { fprintf(stderr, "kernel_launch: occupancy query says %d blocks/CU\n", per_cu); per_cu = 1; }
        if (per_cu > 1) per_cu = 1;
        grid = cus * per_cu;
    }
    if (grid < 0) return;
    Args a{};
    for (int i = 0; i < 20; ++i) a.in[i] = (const float*)d_in[i];
    a.out = (float*)d_out; a.ws = (unsigned char*)d_ws;
#if N_LAUNCH_MODE == 1
    a.ph_lo = 0; a.ph_hi = NPHASE; a.coop = 1;
    hipMemsetAsync((char*)d_ws + WS_BAR, 0, BAR_BYTES, stream);
    void* args[] = {&a};
    hipError_t e = hipLaunchCooperativeKernel((const void*)fwd_kernel, dim3(grid), dim3(512), args, LDS_BYTES, stream);
    if (e != hipSuccess) fprintf(stderr, "cooperative launch failed: %s (grid %d)\n", hipGetErrorString(e), grid);
#else
    for (int ph = 0; ph < NPHASE; ++ph) { a.ph_lo = ph; a.ph_hi = ph + 1; hipLaunchKernelGGL(fwd_kernel, dim3(grid), dim3(512), LDS_BYTES, stream, a); }
#endif
}
```
